# Optimizing an MI355X kernel written in HIP

```python
import jax, jax.numpy as jnp
from jax import lax
import numpy as np

D_MODEL = 2048
BATCH = 1
SEQ = 16384
DEPTH = 2
DEC_BATCH = 8
DEC_SEQ = 16
PAST_LEN = 2048

CHUNK = 64
N_LAYERS_A = DEPTH // 2
N_LAYERS_B = DEPTH - N_LAYERS_A
GLA_HEADS = 4
GLA_DK = D_MODEL // 2
GLA_DV = D_MODEL
GLA_HK = GLA_DK // GLA_HEADS
GLA_HV = GLA_DV // GLA_HEADS
GLA_GATE_RANK = 16
GLA_GATE_NORMALIZER = 16.0
GLA_BLOCK = CHUNK
GLA_IN = 2 * GLA_DK + 2 * GLA_DV + GLA_GATE_RANK
ATT_HEADS = 16
ATT_HD = D_MODEL // ATT_HEADS
PAST_CHUNKS = 8
BAND_PAST = PAST_CHUNKS * CHUNK
BAND = BAND_PAST + CHUNK
MAX_REL = 256
N_REL = 2 * MAX_REL + 1
D_FF = 5504
ALPHA = (2 * DEPTH) ** 0.25
BETA = (8 * DEPTH) ** -0.25
ADA_SCALE = 0.5
LN_EPS = 1e-5
RMS_EPS = 1e-6
NEG = -1e30

kernel_name = 'streaming_gla_chunkband_yoco_trunk'


def layer_norm(x, g, b):
    xf = x.astype(jnp.float32)
    mu = jnp.mean(xf, -1, keepdims=True)
    var = jnp.mean(jnp.square(xf - mu), -1, keepdims=True)
    return ((xf - mu) * lax.rsqrt(var + LN_EPS)).astype(x.dtype) * g + b


def modulate(x, shift, scale):
    return x * (1 + scale[:, None, :]) + shift[:, None, :]


def post_norm(x, y, gate, g, b):
    return layer_norm(ALPHA * x + (1 + gate)[:, None, :] * y, g, b)


def swiglu(h, w_up, w_down):
    a, u = jnp.split(h @ w_up, 2, axis=-1)
    return (jax.nn.silu(a) * u) @ w_down


def gla_chunked(q, k, v, log_a, s0):
    B, T, H, K = q.shape
    V = v.shape[-1]
    L = GLA_BLOCK
    pad = (-T) % L
    f32 = jnp.float32
    if pad:
        pw = ((0, 0), (0, pad), (0, 0), (0, 0))
        q, k, v, log_a = (jnp.pad(t, pw) for t in (q, k, v, log_a))
    N = (T + pad) // L
    qf = q.astype(f32).reshape(B, N, L, H, K)
    kf = k.astype(f32).reshape(B, N, L, H, K)
    vf = v.astype(f32).reshape(B, N, L, H, V)
    b = jnp.cumsum(log_a.astype(f32).reshape(B, N, L, H, K), axis=2)
    b_last = b[:, :, -1:]
    q_t = qf * jnp.exp(b)
    k_t = kf * jnp.exp(-b)
    k_dec = kf * jnp.exp(b_last - b)
    causal = jnp.tril(jnp.ones((L, L), bool))
    scores = jnp.where(causal, jnp.einsum('bnihk,bnjhk->bnhij', q_t, k_t), 0.0)
    o_intra = jnp.einsum('bnhij,bnjhv->bnihv', scores, vf)
    decay = jnp.exp(b_last[:, :, 0])

    def step(S, xs):
        q_n, kd_n, v_n, dec_n = xs
        o = jnp.einsum('blhk,bhkv->blhv', q_n, S)
        S = dec_n[..., None] * S + jnp.einsum('blhk,blhv->bhkv', kd_n, v_n)
        return S, o

    xs = (jnp.moveaxis(q_t, 1, 0), jnp.moveaxis(k_dec, 1, 0), jnp.moveaxis(vf, 1, 0), jnp.moveaxis(decay, 1, 0))
    S, o_inter = lax.scan(step, s0.astype(f32), xs)
    o = (o_intra + jnp.moveaxis(o_inter, 0, 1)).reshape(B, N * L, H, V)[:, :T]
    return o.astype(v.dtype), S.astype(s0.dtype)


def gla_mixer(h, s0, w_in, w_gk2, b_gk, g_norm, w_out):
    B, T, _ = h.shape
    proj = h @ w_in
    cuts = [GLA_DK, 2 * GLA_DK, 2 * GLA_DK + GLA_DV, 2 * GLA_DK + 2 * GLA_DV]
    q, k, v, g, gk_low = jnp.split(proj, cuts, axis=-1)
    log_a = jax.nn.log_sigmoid((gk_low @ w_gk2 + b_gk).astype(jnp.float32)) / GLA_GATE_NORMALIZER
    q = q.reshape(B, T, GLA_HEADS, GLA_HK) * (GLA_HK ** -0.5)
    k = k.reshape(B, T, GLA_HEADS, GLA_HK)
    v = v.reshape(B, T, GLA_HEADS, GLA_HV)
    log_a = log_a.reshape(B, T, GLA_HEADS, GLA_HK)
    o, s_new = gla_chunked(q, k, v, log_a, s0)
    of = o.astype(jnp.float32)
    on = (of * lax.rsqrt(jnp.mean(jnp.square(of), -1, keepdims=True) + RMS_EPS)).astype(h.dtype) * g_norm
    o = on * jax.nn.silu(g.reshape(B, T, GLA_HEADS, GLA_HV))
    return o.reshape(B, T, GLA_DV) @ w_out, s_new


def rel_bias_matrix(table, n_q, n_k, offset):
    dist = offset + jnp.arange(n_q)[:, None] - jnp.arange(n_k)[None, :]
    idx = jnp.clip(dist, -MAX_REL, MAX_REL) + MAX_REL
    return table[:, idx].astype(jnp.float32)


def attend(q, k, v, bias, valid=None):
    s = jnp.einsum('bihd,bjhd->bhij', q, k).astype(jnp.float32) * (ATT_HD ** -0.5) + bias
    if valid is not None:
        s = jnp.where(valid, s, NEG)
    p = jax.nn.softmax(s, axis=-1).astype(v.dtype)
    return jnp.einsum('bhij,bjhd->bihd', p, v)


def band_attention_prompt(q, k, v, table):
    B, T, H, Dh = q.shape
    n_chunks = T // CHUNK
    pw = ((0, 0), (BAND_PAST, 0), (0, 0), (0, 0))
    kp, vp = jnp.pad(k, pw), jnp.pad(v, pw)
    bias = rel_bias_matrix(table, CHUNK, BAND, BAND_PAST)
    key_local = jnp.arange(BAND)

    def one_chunk(n):
        start = n * CHUNK
        qc = lax.dynamic_slice_in_dim(q, start, CHUNK, axis=1)
        kc = lax.dynamic_slice_in_dim(kp, start, BAND, axis=1)
        vc = lax.dynamic_slice_in_dim(vp, start, BAND, axis=1)
        valid = (start - BAND_PAST + key_local) >= 0
        return attend(qc, kc, vc, bias, valid)

    o = lax.map(one_chunk, jnp.arange(n_chunks))
    return jnp.moveaxis(o, 0, 1).reshape(B, T, H, Dh)


def band_attention_sample(q, k_new, v_new, past_k, past_v, table):
    n_past = past_k.shape[1]
    S = q.shape[1]
    k = jnp.concatenate([past_k, k_new], axis=1)
    v = jnp.concatenate([past_v, v_new], axis=1)
    bias = rel_bias_matrix(table, S, n_past + S, n_past)
    return attend(q, k, v, bias)


def shared_kv(x, cs, w_ada_kv, b_ada_kv, w_kv):
    B, T, _ = x.shape
    shift, scale = jnp.split(cs @ w_ada_kv + b_ada_kv, 2, axis=-1)
    k, v = jnp.split(modulate(x, shift, scale) @ w_kv, 2, axis=-1)
    return k.reshape(B, T, ATT_HEADS, ATT_HD), v.reshape(B, T, ATT_HEADS, ATT_HD)


def trunk(x, c, gla_s0, past_k, past_v, w_ada, b_ada, ln_g, ln_b, w_ffn_up, w_ffn_down,
          w_a_in, w_a_gk2, b_a_gk, g_a_norm, w_a_out, w_ada_kv, b_ada_kv, w_kv,
          w_b_q, rel_bias, w_b_out):
    B, T, D = x.shape
    cs = jax.nn.silu(c)
    gla_states = []
    k_sh = v_sh = None
    for l in range(DEPTH):
        if l == N_LAYERS_A:
            k_sh, v_sh = shared_kv(x, cs, w_ada_kv, b_ada_kv, w_kv)
        ada = (cs @ w_ada[l] + b_ada[l]).reshape(B, 3, 3, D)
        y = 0.5 * swiglu(modulate(x, ada[:, 0, 0], ada[:, 0, 1]), w_ffn_up[l, 0], w_ffn_down[l, 0])
        x = post_norm(x, y, ada[:, 0, 2], ln_g[l, 0], ln_b[l, 0])
        h = modulate(x, ada[:, 1, 0], ada[:, 1, 1])
        if l < N_LAYERS_A:
            y, s_new = gla_mixer(h, gla_s0[l], w_a_in[l], w_a_gk2[l], b_a_gk[l], g_a_norm[l], w_a_out[l])
            gla_states.append(s_new)
        else:
            j = l - N_LAYERS_A
            q = (h @ w_b_q[j]).reshape(B, T, ATT_HEADS, ATT_HD)
            if past_k is None:
                o = band_attention_prompt(q, k_sh, v_sh, rel_bias[j])
            else:
                o = band_attention_sample(q, k_sh, v_sh, past_k, past_v, rel_bias[j])
            y = o.reshape(B, T, D) @ w_b_out[j]
        x = post_norm(x, y, ada[:, 1, 2], ln_g[l, 1], ln_b[l, 1])
        y = 0.5 * swiglu(modulate(x, ada[:, 2, 0], ada[:, 2, 1]), w_ffn_up[l, 1], w_ffn_down[l, 1])
        x = post_norm(x, y, ada[:, 2, 2], ln_g[l, 2], ln_b[l, 2])
    return x, jnp.stack(gla_states), k_sh, v_sh


def setup_inputs(seed: int = 0) -> dict:
    key = jax.random.key(seed)
    ks = iter(jax.random.split(key, 40))

    def nrm(shape, s=1.0):
        return jax.random.normal(next(ks), shape, jnp.float32) * s

    D = D_MODEL
    n_band = min(BAND_PAST, PAST_LEN)
    inv_d = D ** -0.5
    w_a_in = jnp.concatenate([
        nrm((N_LAYERS_A, D, 2 * GLA_DK), inv_d),
        nrm((N_LAYERS_A, D, GLA_DV), inv_d * BETA),
        nrm((N_LAYERS_A, D, GLA_DV + GLA_GATE_RANK), inv_d)], axis=-1)
    w_kv = jnp.concatenate([nrm((D, D), inv_d), nrm((D, D), inv_d * BETA)], axis=-1)
    return {
        'x_prompt': nrm((BATCH, SEQ, D)),
        'x_sample': nrm((DEC_BATCH, DEC_SEQ, D)),
        'state_gla': nrm((N_LAYERS_A, DEC_BATCH, GLA_HEADS, GLA_HK, GLA_HV)),
        'cache_band_k': nrm((DEC_BATCH, n_band, ATT_HEADS, ATT_HD)),
        'cache_band_v': nrm((DEC_BATCH, n_band, ATT_HEADS, ATT_HD)),
        'c_prompt': nrm((BATCH, D)),
        'c_sample': nrm((DEC_BATCH, D)),
        'w_ada': nrm((DEPTH, D, 9 * D), ADA_SCALE * inv_d),
        'b_ada': nrm((DEPTH, 9 * D), 0.02),
        'ln_g': 1.0 + nrm((DEPTH, 3, D), 0.02),
        'ln_b': nrm((DEPTH, 3, D), 0.02),
        'w_ffn_up': nrm((DEPTH, 2, D, 2 * D_FF), inv_d),
        'w_ffn_down': nrm((DEPTH, 2, D_FF, D), D_FF ** -0.5 * BETA),
        'w_a_in': w_a_in,
        'w_a_gk2': nrm((N_LAYERS_A, GLA_GATE_RANK, GLA_DK), GLA_GATE_RANK ** -0.5),
        'b_a_gk': nrm((N_LAYERS_A, GLA_DK), 0.1),
        'g_a_norm': 1.0 + nrm((N_LAYERS_A, GLA_HV), 0.02),
        'w_a_out': nrm((N_LAYERS_A, GLA_DV, D), GLA_DV ** -0.5 * BETA),
        'w_ada_kv': nrm((D, 2 * D), ADA_SCALE * inv_d),
        'b_ada_kv': nrm((2 * D,), 0.02),
        'w_kv': w_kv,
        'w_b_q': nrm((N_LAYERS_B, D, D), inv_d),
        'rel_bias': nrm((N_LAYERS_B, ATT_HEADS, N_REL), 0.5),
        'w_b_out': nrm((N_LAYERS_B, D, D), inv_d * BETA),
    }


def reference(x_prompt, x_sample, state_gla, cache_band_k, cache_band_v, c_prompt, c_sample,
              w_ada, b_ada, ln_g, ln_b, w_ffn_up, w_ffn_down, w_a_in, w_a_gk2, b_a_gk,
              g_a_norm, w_a_out, w_ada_kv, b_ada_kv, w_kv, w_b_q, rel_bias, w_b_out):
    gla_zero = jnp.zeros((N_LAYERS_A, x_prompt.shape[0], GLA_HEADS, GLA_HK, GLA_HV), state_gla.dtype)
    y_prompt, s_gla_p, k_p, v_p = trunk(
        x_prompt, c_prompt, gla_zero, None, None, w_ada, b_ada, ln_g, ln_b, w_ffn_up, w_ffn_down,
        w_a_in, w_a_gk2, b_a_gk, g_a_norm, w_a_out, w_ada_kv, b_ada_kv, w_kv, w_b_q, rel_bias, w_b_out)
    y_sample, s_gla_s, k_s, v_s = trunk(
        x_sample, c_sample, state_gla, cache_band_k, cache_band_v, w_ada, b_ada, ln_g, ln_b,
        w_ffn_up, w_ffn_down, w_a_in, w_a_gk2, b_a_gk, g_a_norm, w_a_out, w_ada_kv, b_ada_kv,
        w_kv, w_b_q, rel_bias, w_b_out)
    n_keep = min(BAND_PAST, x_prompt.shape[1])
    k_p_new = k_p[:, -n_keep:]
    v_p_new = v_p[:, -n_keep:]
    return (y_prompt, y_sample, s_gla_p, s_gla_s, k_p_new, v_p_new, k_s, v_s)
```

```cpp
#include <hip/hip_runtime.h>
#include <cstdio>
#include <cstdint>
#ifndef PG8_ALIGN_EPI
#define PG8_ALIGN_EPI true
#endif
#ifndef PG8_WGM
#define PG8_WGM 4
#endif
#ifndef PG8_SP2
#define PG8_SP2 true
#endif
constexpr int NWAVES = 8;
constexpr int D = 2048, TP = 16384, NSR = 128, MR = 16512, MP = 16640, FF = 5504, FF2 = 11008;
constexpr int NCH = 264;
constexpr int ADA_LD = 40960;
constexpr float LN_EPS = 1e-5f, RMS_EPS = 1e-6f;
constexpr size_t O_YP = 0, O_YS = 33554432, O_SP = 33816576, O_SS = 34340864, O_KP = 38535168, O_VP = 39583744, O_KS = 40632320, O_VS = 40894464;
constexpr size_t MiB = 1u << 20;
constexpr size_t WS_CTL = 0, CTL_ZERO_BYTES = 1 * MiB;
constexpr size_t WS_ADA = 1 * MiB;
constexpr size_t SZ_WUP = (size_t)FF2 * D * 2, SZ_WDN = (size_t)D * FF * 2, SZ_SQ = (size_t)D * D * 2;
constexpr size_t WS_WUP = 3 * MiB;
constexpr size_t WS_WDN = WS_WUP + 4 * SZ_WUP;
constexpr size_t WS_WAN = WS_WDN + 4 * SZ_WDN;
constexpr size_t WS_WAV = WS_WAN + (size_t)4352 * D * 2;
constexpr size_t WS_WAO = WS_WAV + SZ_SQ;
constexpr size_t WS_WK = WS_WAO + SZ_SQ, WS_WV = WS_WK + SZ_SQ, WS_WQ = WS_WV + SZ_SQ, WS_WBO = WS_WQ + SZ_SQ;
constexpr size_t WS_VTC = WS_WBO + SZ_SQ;
constexpr size_t SZ_F32ACT = (size_t)MP * D * 4, SZ_B16ACT = (size_t)MP * D * 2;
constexpr size_t WS_ZSP = WS_VTC + (size_t)8 * 2048 * 512 * 2;
constexpr size_t WS_XS = WS_ZSP + (size_t)21 * 128 * D * 4;
constexpr size_t WS_STAT = WS_XS + (size_t)128 * D * 4;
constexpr size_t WS_XA = WS_STAT + (size_t)TP * 2 * 4;
constexpr size_t WS_ZB0 = WS_XA, WS_ZB1 = WS_XA + SZ_B16ACT;
constexpr size_t WS_Z = WS_XA + SZ_F32ACT;
constexpr size_t WS_H = WS_Z + SZ_F32ACT;
constexpr size_t WS_H2 = WS_H + SZ_B16ACT;
constexpr size_t WS_R1 = WS_H2 + SZ_B16ACT;
constexpr size_t WS_HID = WS_R1;
constexpr size_t SZ_HID = (size_t)MP * FF * 2;
constexpr size_t WS_QG = WS_R1, WS_KG = WS_QG + (size_t)MP * 1024 * 2, WS_GG = WS_KG + (size_t)MP * 1024 * 2, WS_VTG = WS_GG + SZ_B16ACT;
constexpr size_t WS_GKL = WS_VTG + SZ_B16ACT;
constexpr size_t WS_QT = WS_GKL + (size_t)MP * 16 * 4;
constexpr size_t SZ_QT = (size_t)NCH * 4 * 64 * 256 * 2;
constexpr size_t WS_KDT = WS_QT + SZ_QT;
constexpr size_t WS_P = WS_KDT + SZ_QT;
constexpr size_t WS_DEC = WS_P + (size_t)NCH * 4 * 64 * 64 * 2;
constexpr size_t WS_UT = WS_DEC + (size_t)NCH * 4 * 256 * 4;
constexpr size_t WS_GLA_END = WS_UT + (size_t)NCH * 4 * 512 * 256 * 2;
constexpr size_t WS_KB = WS_R1 + ((SZ_HID + 255) / 256) * 256;
constexpr size_t WS_VTB = WS_KB + SZ_B16ACT;
constexpr size_t WS_ATT_END = WS_VTB + SZ_B16ACT;
constexpr size_t WS_END = WS_GLA_END > WS_ATT_END ? WS_GLA_END : WS_ATT_END;
static_assert(WS_END <= (size_t)1442840576, "d_ws map exceeds the guaranteed workspace (4 x largest input)");
static_assert(WS_WUP % 256 == 0 && WS_WDN % 256 == 0 && WS_XA % 256 == 0 && WS_R1 % 256 == 0 && WS_KB % 256 == 0 && WS_QT % 256 == 0 && WS_UT % 256 == 0 && WS_P % 256 == 0 && WS_DEC % 256 == 0, "alignment");
constexpr int CW_BAR = 4096, CW_WORK = 2048;
constexpr int RING_BYTES = 131072, LDS_BYTES = 147456, LDSCTL_OFF = LDS_BYTES - 512, MISC_OFF = LDSCTL_OFF + 320;

struct Args { const float* in[24]; float* out; unsigned char* ws; };
typedef const __attribute__((address_space(4))) Args* ArgsP;
__device__ __forceinline__ int fresh_tid() { int t; asm volatile("v_mov_b32 %0, %1" : "=v"(t) : "v"(threadIdx.x)); return t; }
#ifndef WT_STORES
#define WT_STORES 0
#endif
template <class V> __device__ __forceinline__ void st16_wt(void* p, const V& v) {
    static_assert(sizeof(V) == 16, "st16_wt stores 16 bytes");
#if WT_STORES
    asm volatile("global_store_dwordx4 %0, %1, off sc1\n\ts_nop 2" :: "v"(p), "v"(v) : "memory");
#else
    *(V*)p = v;
#endif
}
#define GAS __attribute__((address_space(1)))
#define LAS __attribute__((address_space(3)))
typedef unsigned short bf16;
typedef unsigned v4u __attribute__((ext_vector_type(4)));
typedef unsigned v2u __attribute__((ext_vector_type(2)));
typedef float f32x4 __attribute__((ext_vector_type(4)));
typedef float f32x2v __attribute__((ext_vector_type(2)));
typedef short bf16x8 __attribute__((ext_vector_type(8)));
typedef short s16x4 __attribute__((ext_vector_type(4)));
#define LDS_WAIT() asm volatile("s_waitcnt lgkmcnt(0)" ::: "memory")
#define VM_WAIT() asm volatile("s_waitcnt vmcnt(0)" ::: "memory")
__device__ __forceinline__ unsigned f2bf(float f) { unsigned u = __builtin_bit_cast(unsigned, f); return (u + 0x7fffu + ((u >> 16) & 1u)) >> 16; }
typedef __bf16 bf16x2_t __attribute__((ext_vector_type(2)));
__device__ __forceinline__ unsigned pk2(float lo, float hi) { const f32x2v v = {lo, hi}; const bf16x2_t b = __builtin_convertvector(v, bf16x2_t); return __builtin_bit_cast(unsigned, b); }
__device__ __forceinline__ float bf2f(unsigned short b) { return __builtin_bit_cast(float, ((unsigned)b) << 16); }
__device__ __forceinline__ float wave_sum(float v) {
#pragma unroll
    for (int o = 1; o < 64; o <<= 1) v += __shfl_xor(v, o);
    return v;
}
__device__ __forceinline__ void swap16(float& a, float& b) { asm("s_nop 1\n\tv_permlane16_swap_b32 %0, %1" : "+v"(a), "+v"(b)); }
__device__ __forceinline__ void swap32(float& a, float& b) { asm("s_nop 1\n\tv_permlane32_swap_b32 %0, %1" : "+v"(a), "+v"(b)); }
__device__ __forceinline__ float rows_max(float x) { float a = x, b = x; swap16(a, b); float t = fmaxf(a, b); a = t; b = t; swap32(a, b); return fmaxf(a, b); }
__device__ __forceinline__ float rows_sum(float x) { float a = x, b = x; swap16(a, b); float t = a + b; a = t; b = t; swap32(a, b); return a + b; }
__device__ __forceinline__ float silu(float a) { return a / (1.0f + __expf(-a)); }
#define MFMA16(a, b, c) __builtin_amdgcn_mfma_f32_16x16x32_bf16((a), (b), (c), 0, 0, 0)
constexpr int FFc = 5504;
__device__ __forceinline__ int tr_nmap(int kind, int n, int coff) {
    if (kind == 1) {
        const int pn = n >> 8, bj = (n >> 7) & 1, wc = (n >> 5) & 3, fq = (n >> 3) & 3, nn = (n >> 2) & 1, i = n & 3;
        return nn * FFc + 128 * pn + 32 * wc + 16 * bj + 4 * fq + i;
    }
    if (kind == 3) {
        if (n < 2048) return n;
        if (n < 4096) return 4096 + (n - 2048);
        if (n < 4112) return 6144 + (n - 4096);
        return -1;
    }
    return n + coff;
}
__device__ __forceinline__ int tr_kmap(int kind, int k) {
    if (kind == 2) return (k & ~31) | (((k >> 2) & 1) << 4) | (((k >> 3) & 3) << 2) | (k & 3);
    return k;
}
constexpr int I_UP = 256 * 43, I_DN = 688 * 8, I_AN = 256 * 17, I_SQ = 256 * 8, I_CV = 64 * 8;
constexpr int CV_B1 = I_UP;
constexpr int CV_B2 = CV_B1 + I_DN + I_AN + 2 * I_SQ + I_UP + I_DN;
constexpr int CV_B3 = CV_B2 + 2 * I_SQ + I_UP + I_DN + 2 * I_SQ;
constexpr int CV_END = CV_B3 + I_UP + I_DN + 8 * I_CV;
__device__ __forceinline__ void cv_item(ArgsP a, int it, int lane) {
    const float* W; unsigned char* ws = a->ws; bf16* WT; int ldw, ldt, nblk, kind = 0, coff = 0; int r = it;
#define CV_UP(m) { W = a->in[11] + (size_t)(m) * 2048 * 11008; ldw = 11008; ldt = 2048; nblk = 43; kind = 1; WT = (bf16*)(ws + WS_WUP + (size_t)(m) * SZ_WUP); }
#define CV_DN(m) { W = a->in[12] + (size_t)(m) * 5504 * 2048; ldw = 2048; ldt = 5504; nblk = 8; kind = 2; WT = (bf16*)(ws + WS_WDN + (size_t)(m) * SZ_WDN); }
#define CV_SQ(src, ld, co, dst) { W = (src); ldw = (ld); ldt = 2048; nblk = 8; coff = (co); WT = (bf16*)(ws + (dst)); }
    if (r < I_UP) CV_UP(0)
    else if ((r -= I_UP) < I_DN) CV_DN(0)
    else if ((r -= I_DN) < I_AN) { W = a->in[13]; ldw = 6160; ldt = 2048; nblk = 17; kind = 3; WT = (bf16*)(ws + WS_WAN); }
    else if ((r -= I_AN) < I_SQ) CV_SQ(a->in[13], 6160, 2048, WS_WAV)
    else if ((r -= I_SQ) < I_SQ) CV_SQ(a->in[17], 2048, 0, WS_WAO)
    else if ((r -= I_SQ) < I_UP) CV_UP(1)
    else if ((r -= I_UP) < I_DN) CV_DN(1)
    else if ((r -= I_DN) < I_SQ) CV_SQ(a->in[20], 4096, 0, WS_WK)
    else if ((r -= I_SQ) < I_SQ) CV_SQ(a->in[20], 4096, 2048, WS_WV)
    else if ((r -= I_SQ) < I_UP) CV_UP(2)
    else if ((r -= I_UP) < I_DN) CV_DN(2)
    else if ((r -= I_DN) < I_SQ) CV_SQ(a->in[21], 2048, 0, WS_WQ)
    else if ((r -= I_SQ) < I_SQ) CV_SQ(a->in[23], 2048, 0, WS_WBO)
    else if ((r -= I_SQ) < I_UP) CV_UP(3)
    else if ((r -= I_UP) < I_DN) CV_DN(3)
    else { r -= I_DN; const int b = r / I_CV; r -= b * I_CV; W = a->in[4] + (size_t)b * 512 * 2048; ldw = 2048; ldt = 512; nblk = 8; WT = (bf16*)(ws + WS_VTC + (size_t)b * 2048 * 512 * 2); }
#undef CV_UP
#undef CV_DN
#undef CV_SQ
    const int kb = r / nblk, nb = r - kb * nblk, k0 = 8 * kb, nrow = 256 * nb + 4 * lane;
    const int col = tr_nmap(kind, nrow, coff);
    f32x4 v[8];
#pragma unroll
    for (int e = 0; e < 8; ++e) { v[e] = (f32x4){0.f, 0.f, 0.f, 0.f}; if (col >= 0) v[e] = __builtin_nontemporal_load((const f32x4*)(W + (size_t)tr_kmap(kind, k0 + e) * ldw + col)); }
#pragma unroll
    for (int j = 0; j < 4; ++j) {
        const v4u o = {pk2(v[0][j], v[1][j]), pk2(v[2][j], v[3][j]), pk2(v[4][j], v[5][j]), pk2(v[6][j], v[7][j])};
        *(v4u*)(WT + (size_t)(nrow + j) * ldt + k0) = o; }
}
__device__ __forceinline__ void cv_gap(ArgsP a, int lo, int hi, int g, int per, bool flush, int gw, int NGW, int lane) {
    for (int j = 0; flush || j < per; ++j) {
        const int it = lo + (g * per + j) * NGW + gw;
        if (it >= hi) break;
        cv_item(a, it, lane);
    }
}
namespace pg8 {
#define PG8_LAS __attribute__((address_space(3)))
typedef unsigned short bf16_t;
typedef short bf16x8 __attribute__((ext_vector_type(8)));
typedef float f32x4 __attribute__((ext_vector_type(4)));
typedef unsigned u32x4 __attribute__((ext_vector_type(4)));
constexpr int BM = 256, BK = 64, HALF = 128, HTB = HALF * BK * 2  , STAGE_BYTES = 8 * HTB, NXCD = 8, WGM = PG8_WGM;

__host__ __device__ __forceinline__ int lds_byte(int r, int c) { const int st = (r >> 4) * 2 + (c >> 5), rr = r & 15, cc = c & 31, ob = rr * 64 + cc * 2; return st * 1024 + (ob ^ (((ob >> 9) & 1) << 5)); }
__host__ __device__ __forceinline__ void stage_rc(int b, int& R, int& C) { const int st = b / 1024, sb = b % 1024, swz = sb ^ (((sb >> 9) & 1) << 5); R = (st >> 1) * 16 + swz / 64; C = (st & 1) * 32 + (swz % 64) / 2; }
__host__ __device__ __forceinline__ int perm32(int rho) { const int n = rho >> 4, i = rho & 15; return 8 * (i >> 2) + 4 * n + (i & 3); }

struct Unit { int pm, pn; };
struct Gemm { const bf16_t* A; const bf16_t* Bt; int M, N, K; };

struct StaticOrder {
    int nM, nN, nwg, G, c;
    __host__ __device__ void init(int M, int N, int G_, int c_) { nM = M / BM; nN = N / BM; nwg = nM * nN; G = G_; c = c_; }
    __host__ __device__ bool next(int i, Unit& u) const {
        const long L = (long)i * G + c; if (L >= nwg) return false;
        int wgid = (int)L; { const int q = nwg / NXCD, r = nwg % NXCD, xcd = wgid % NXCD, off = wgid / NXCD; wgid = (xcd < r ? xcd * (q + 1) : r * (q + 1) + (xcd - r) * q) + off; }
        const int nig = WGM * nN, gid = wgid / nig, fm = gid * WGM, gsz = (nM - fm) < WGM ? (nM - fm) : WGM;
        u.pm = fm + ((wgid % nig) % gsz); u.pn = (wgid % nig) / gsz; return true;
    }
    __device__ __forceinline__ void a_ready(const Unit&) const {}
    __device__ __forceinline__ void done(const Unit&) const {}
};

__device__ __forceinline__ unsigned cvt_pk_bf16(float lo, float hi) { unsigned r; asm volatile("v_cvt_pk_bf16_f32 %0, %1, %2" : "=v"(r) : "v"(lo), "v"(hi)); return r; }
constexpr int E_D = 2048, E_TP = 16384, E_MR = 16512, E_MP = 16640, E_FF = 5504, E_ADA_LD = 40960;
typedef float f32x2 __attribute__((ext_vector_type(2)));
constexpr float E_ALPHA = 1.41421356237309515f;
__device__ __forceinline__ float silu_f(float a) { return a * __builtin_amdgcn_rcpf(1.0f + __expf(-a)); }
struct UnitX { int g, pm, pn, kt0, nkt; };
template <int NM0, int NN0, int NM1, int NN1, int NM2, int NN2, int NPCS, int PCS_NN, int NKT>
struct SegOrder {
    int G, c;
    static constexpr int C0 = NM0 * NN0, C1 = NM1 * NN1, C2 = NM2 * NN2, CP = NPCS * PCS_NN, TOT = C0 + C1 + C2 + CP;
    __device__ __forceinline__ bool next(int i, UnitX& u) const {
        int L = i * G + c; if (L >= TOT) return false;
        int g = 0, nM = NM0, nN = NN0; bool piece = false;
        if (L >= C0) { L -= C0; g = 1; nM = NM1; nN = NN1;
            if (L >= C1) { L -= C1; g = 2; nM = NM2; nN = NN2;
                if (L >= C2) { L -= C2; g = 3; piece = true; nM = 1; nN = 1; } } }
        constexpr int PNN = PCS_NN > 0 ? PCS_NN : 1;
        const int pc = L / PNN, ppn = L - pc * PNN;
        const int nwg = nM * nN;
        int wgid = piece ? 0 : L; { const int q = nwg / NXCD, r = nwg % NXCD, xcd = wgid % NXCD, off = wgid / NXCD; wgid = (xcd < r ? xcd * (q + 1) : r * (q + 1) + (xcd - r) * q) + off; }
        const int nig = WGM * nN, gid = wgid / nig, fm = gid * WGM, gsz = (nM - fm) < WGM ? (nM - fm) : WGM;
        const int pm_n = fm + ((wgid % nig) % gsz), pn_n = (wgid % nig) / gsz;
        u.g = g; u.pm = piece ? 64 : pm_n; u.pn = piece ? ppn : pn_n; u.kt0 = piece ? 4 * pc : 0; u.nkt = piece ? ((pc == NPCS - 1) ? NKT - 4 * (NPCS - 1) : 4) : NKT;
        return true;
    }
};
__device__ __forceinline__ void epi_up(const f32x4 (&acc)[2][2][4][2], const UnitX& u, int wr, int wc, int fr, int fq, bf16_t* Hd) {
    const int row0 = u.pm * BM + wr * 64 + fr, p0 = u.pn * 128 + wc * 32 + 8 * fq;
#pragma unroll
    for (int ai = 0; ai < 2; ++ai)
#pragma unroll
        for (int m = 0; m < 4; ++m) {
            const int row = row0 + ai * HALF + m * 16;
            const f32x4 a0 = acc[ai][0][m][0], u0 = acc[ai][0][m][1], a1 = acc[ai][1][m][0], u1 = acc[ai][1][m][1];
            u32x4 w;
            w.x = cvt_pk_bf16(silu_f(a0[0]) * u0[0], silu_f(a0[1]) * u0[1]); w.y = cvt_pk_bf16(silu_f(a0[2]) * u0[2], silu_f(a0[3]) * u0[3]);
            w.z = cvt_pk_bf16(silu_f(a1[0]) * u1[0], silu_f(a1[1]) * u1[1]); w.w = cvt_pk_bf16(silu_f(a1[2]) * u1[2], silu_f(a1[3]) * u1[3]);
            st16_wt(Hd + (size_t)row * E_FF + p0, w);
        }
}
template <int XMODE, int OUTF32>
__device__ __forceinline__ void epi_res(const f32x4 (&acc)[2][2][4][2], const UnitX& u, int wr, int wc, int fr, int fq, const void* xsrc, const float* stat, const float* lg, const float* lb, void* zdst, const float* gate, float s) {
    const int row0 = u.pm * BM + wr * 64 + fr, col0 = u.pn * BM + wc * 32 + 8 * fq;
    f32x4 g1[2][2], ag[2][2], ab[2][2];
#pragma unroll
    for (int bj = 0; bj < 2; ++bj)
#pragma unroll
        for (int n = 0; n < 2; ++n) { const int c = col0 + bj * HALF + 4 * n; g1[bj][n] = (*(const f32x4*)(gate + c) + 1.0f) * s;
            if (XMODE) { ag[bj][n] = *(const f32x4*)(lg + c) * E_ALPHA; ab[bj][n] = *(const f32x4*)(lb + c) * E_ALPHA; } }
#pragma unroll
    for (int ai = 0; ai < 2; ++ai)
#pragma unroll
        for (int m = 0; m < 4; ++m) {
            const int row = row0 + ai * HALF + m * 16; const size_t ro = (size_t)row * E_D;
            float mu = 0.f, rs = 1.f; if (XMODE) { const f32x2 st = *(const f32x2*)(stat + 2 * (size_t)row); mu = st.x; rs = st.y; }
#pragma unroll
            for (int bj = 0; bj < 2; ++bj) { const int c = col0 + bj * HALF;
                f32x4 z0, z1;
                if (XMODE) { const u32x4 w = *(const u32x4*)((const bf16_t*)xsrc + ro + c);
                    const f32x4 t0 = {__uint_as_float(w.x << 16), __uint_as_float(w.x & 0xffff0000u), __uint_as_float(w.y << 16), __uint_as_float(w.y & 0xffff0000u)};
                    const f32x4 t1 = {__uint_as_float(w.z << 16), __uint_as_float(w.z & 0xffff0000u), __uint_as_float(w.w << 16), __uint_as_float(w.w & 0xffff0000u)};
                    z0 = (t0 - mu) * rs * ag[bj][0] + ab[bj][0] + g1[bj][0] * acc[ai][bj][m][0];
                    z1 = (t1 - mu) * rs * ag[bj][1] + ab[bj][1] + g1[bj][1] * acc[ai][bj][m][1];
                } else { const f32x4 x0 = *(const f32x4*)((const float*)xsrc + ro + c), x1 = *(const f32x4*)((const float*)xsrc + ro + c + 4);
                    z0 = x0 * E_ALPHA + g1[bj][0] * acc[ai][bj][m][0]; z1 = x1 * E_ALPHA + g1[bj][1] * acc[ai][bj][m][1]; }
                if (OUTF32) { *(f32x4*)((float*)zdst + ro + c) = z0; *(f32x4*)((float*)zdst + ro + c + 4) = z1; }
                else { u32x4 w; w.x = cvt_pk_bf16(z0[0], z0[1]); w.y = cvt_pk_bf16(z0[2], z0[3]); w.z = cvt_pk_bf16(z1[0], z1[1]); w.w = cvt_pk_bf16(z1[2], z1[3]); st16_wt((bf16_t*)zdst + ro + c, w); }
            }
            asm volatile("" ::: "memory");
        }
}
__device__ __forceinline__ void epi_part(const f32x4 (&acc)[2][2][4][2], const UnitX& u, int wr, int wc, int fr, int fq, float* ZSP) {
    const int r0 = wr * 64 + fr, col0 = u.pn * BM + wc * 32 + 8 * fq; float* base = ZSP + (size_t)(u.kt0 >> 2) * 128 * E_D;
#pragma unroll
    for (int m = 0; m < 4; ++m) {
        float* zr = base + (size_t)(r0 + m * 16) * E_D;
#pragma unroll
        for (int bj = 0; bj < 2; ++bj)
#pragma unroll
            for (int n = 0; n < 2; ++n) st16_wt(zr + col0 + bj * HALF + 4 * n, acc[0][bj][m][n]);
    }
}
__device__ __forceinline__ void epi_b16(const f32x4 (&acc)[2][2][4][2], const UnitX& u, int wr, int wc, int fr, int fq, bf16_t* O, int ldc, int colt, float sc) {
    const int row0 = u.pm * BM + wr * 64 + fr, col0 = colt + wc * 32 + 8 * fq;
#pragma unroll
    for (int ai = 0; ai < 2; ++ai)
#pragma unroll
        for (int m = 0; m < 4; ++m) {
            const int row = row0 + ai * HALF + m * 16;
#pragma unroll
            for (int bj = 0; bj < 2; ++bj) {
                const f32x4 v0 = acc[ai][bj][m][0] * sc, v1 = acc[ai][bj][m][1] * sc;
                u32x4 w; w.x = cvt_pk_bf16(v0[0], v0[1]); w.y = cvt_pk_bf16(v0[2], v0[3]); w.z = cvt_pk_bf16(v1[0], v1[1]); w.w = cvt_pk_bf16(v1[2], v1[3]);
                st16_wt(O + (size_t)row * ldc + col0 + bj * HALF, w);
            }
        }
}
__device__ __forceinline__ void epi_kout(const f32x4 (&acc)[2][2][4][2], const UnitX& u, int wr, int wc, int fr, int fq, float* fp, int fdelta) {
    if (u.pm < 62) return;
    const int row0 = u.pm * BM + wr * 64 + fr, col0 = u.pn * BM + wc * 32 + 8 * fq;
#pragma unroll
    for (int ai = 0; ai < 2; ++ai)
#pragma unroll
        for (int m = 0; m < 4; ++m) {
            const int row = row0 + ai * HALF + m * 16;
            if (row < E_MR) {
                float* dst = fp + (row < E_TP ? (size_t)(row - (E_TP - 512)) * E_D : (size_t)fdelta + (size_t)(row - E_TP) * E_D);
#pragma unroll
                for (int bj = 0; bj < 2; ++bj) { *(f32x4*)(dst + col0 + bj * HALF) = acc[ai][bj][m][0]; *(f32x4*)(dst + col0 + bj * HALF + 4) = acc[ai][bj][m][1]; }
            }
        }
}
__device__ __forceinline__ void epi_vout(const f32x4 (&acc)[2][2][4][2], const UnitX& u, int wr, int wc, int fr, int fq, float* fp, int fdelta) {
    if (u.pn < 62) return;
    const int row0 = u.pm * BM + wr * 64 + fr, col0 = u.pn * BM + wc * 32 + 8 * fq;
#pragma unroll
    for (int ai = 0; ai < 2; ++ai)
#pragma unroll
        for (int m = 0; m < 4; ++m) {
            const int row = row0 + ai * HALF + m * 16;
#pragma unroll
            for (int bj = 0; bj < 2; ++bj)
#pragma unroll
                for (int j = 0; j < 8; ++j) { const int t = col0 + bj * HALF + j; const float v = j < 4 ? acc[ai][bj][m][0][j & 3] : acc[ai][bj][m][1][j & 3];
                    if (t < E_MR) fp[(t < E_TP ? (size_t)(t - (E_TP - 512)) * E_D : (size_t)fdelta + (size_t)(t - E_TP) * E_D) + row] = v; }
        }
}
#define OPS_AP ArgsP ap = a; asm volatile("" : "+s"(ap))
template <size_t WOFF, int CVLO, int CVHI, int CVPER> struct OpsUp {
    static constexpr int KROW = E_D; ArgsP a; int G;
    __device__ __forceinline__ void gap(int ui, bool last, int tid) const { if (CVHI > CVLO) { OPS_AP; cv_gap(ap, CVLO, CVHI, ui, CVPER, last, (int)blockIdx.x * 8 + (tid >> 6), G * 8, tid & 63); } }
    __device__ __forceinline__ const char* abase(int) const { return (const char*)(a->ws + WS_H); }
    __device__ __forceinline__ const char* bbase(int) const { return (const char*)(a->ws + WOFF); }
    __device__ __forceinline__ void operator()(const f32x4 (&acc)[2][2][4][2], const UnitX& u, int wr, int wc, int fr, int fq) const { OPS_AP; epi_up(acc, u, wr, wc, fr, fq, (bf16_t*)(ap->ws + WS_HID)); }
};
template <size_t AOFF, size_t WOFF, int KR, int SUB, int GOFF, int SHALF> struct OpsRes {
    static constexpr int KROW = KR; ArgsP a; int G;
    __device__ __forceinline__ void gap(int, bool, int) const {}
    __device__ __forceinline__ const char* abase(int) const { return (const char*)(a->ws + AOFF); }
    __device__ __forceinline__ const char* bbase(int) const { return (const char*)(a->ws + WOFF); }
    __device__ __forceinline__ void operator()(const f32x4 (&acc)[2][2][4][2], const UnitX& u, int wr, int wc, int fr, int fq) const { OPS_AP;
        if (u.g == 0) {
            const void* xsrc = SUB == 0 ? (const void*)ap->in[0] : (const void*)(ap->ws + (((SUB - 1) & 1) ? WS_ZB1 : WS_ZB0));
            void* zdst = (void*)(ap->ws + ((SUB & 1) ? WS_ZB1 : WS_ZB0));
            constexpr int PS = SUB > 0 ? SUB - 1 : 0;
            epi_res<(SUB > 0), 0>(acc, u, wr, wc, fr, fq, xsrc, (const float*)(ap->ws + WS_STAT), ap->in[9] + PS * E_D, ap->in[10] + PS * E_D, zdst, (const float*)(ap->ws + WS_ADA) + GOFF, SHALF ? 0.5f : 1.0f);
        } else epi_part(acc, u, wr, wc, fr, fq, (float*)(ap->ws + WS_ZSP)); }
};
struct OpsAin {
    static constexpr int KROW = E_D; ArgsP a; int G;
    __device__ __forceinline__ void gap(int, bool, int) const {}
    __device__ __forceinline__ const char* abase(int g) const { return (const char*)(a->ws + (g == 0 ? WS_H : WS_WAV)); }
    __device__ __forceinline__ const char* bbase(int g) const { return (const char*)(a->ws + (g == 0 ? WS_WAN : WS_H)); }
    __device__ __forceinline__ void operator()(const f32x4 (&acc)[2][2][4][2], const UnitX& u, int wr, int wc, int fr, int fq) const { OPS_AP;
        if (u.g == 1) { epi_b16(acc, u, wr, wc, fr, fq, (bf16_t*)(ap->ws + WS_VTG), E_MP, u.pn * BM, 1.0f); return; }
        const int pn = u.pn;
        if (pn < 4) epi_b16(acc, u, wr, wc, fr, fq, (bf16_t*)(ap->ws + WS_QG), 1024, pn * BM, 0.0625f);
        else if (pn < 8) epi_b16(acc, u, wr, wc, fr, fq, (bf16_t*)(ap->ws + WS_KG), 1024, (pn - 4) * BM, 1.0f);
        else if (pn < 16) epi_b16(acc, u, wr, wc, fr, fq, (bf16_t*)(ap->ws + WS_GG), 2048, (pn - 8) * BM, 1.0f);
        else if (wc == 0 && fq < 2) { float* GKL = (float*)(ap->ws + WS_GKL); const int row0 = u.pm * BM + wr * 64 + fr;
#pragma unroll
            for (int ai = 0; ai < 2; ++ai)
#pragma unroll
                for (int m = 0; m < 4; ++m) { float* dst = GKL + (size_t)(row0 + ai * HALF + m * 16) * 16 + 8 * fq; *(f32x4*)dst = acc[ai][0][m][0]; *(f32x4*)(dst + 4) = acc[ai][0][m][1]; } }
    }
};
template <size_t WUPOFF, int CVLO, int CVHI, int CVPER> struct OpsKVUp {
    static constexpr int KROW = E_D; ArgsP a; int G;
    __device__ __forceinline__ void gap(int ui, bool last, int tid) const { if (CVHI > CVLO) { OPS_AP; cv_gap(ap, CVLO, CVHI, ui, CVPER, last, (int)blockIdx.x * 8 + (tid >> 6), G * 8, tid & 63); } }
    __device__ __forceinline__ const char* abase(int g) const { return (const char*)(a->ws + (g == 0 ? WS_H2 : (g == 1 ? WS_WV : WS_H))); }
    __device__ __forceinline__ const char* bbase(int g) const { return (const char*)(a->ws + (g == 0 ? WS_WK : (g == 1 ? WS_H2 : WUPOFF))); }
    __device__ __forceinline__ void operator()(const f32x4 (&acc)[2][2][4][2], const UnitX& u, int wr, int wc, int fr, int fq) const { OPS_AP;
        if (u.g == 2) epi_up(acc, u, wr, wc, fr, fq, (bf16_t*)(ap->ws + WS_HID));
        else if (u.g == 0) { epi_b16(acc, u, wr, wc, fr, fq, (bf16_t*)(ap->ws + WS_KB), E_D, u.pn * BM, 1.0f); epi_kout(acc, u, wr, wc, fr, fq, ap->out + O_KP, (int)(O_KS - O_KP)); }
        else { epi_b16(acc, u, wr, wc, fr, fq, (bf16_t*)(ap->ws + WS_VTB), E_MP, u.pn * BM, 1.0f); epi_vout(acc, u, wr, wc, fr, fq, ap->out + O_VP, (int)(O_VS - O_VP)); } }
};
struct OpsQ {
    static constexpr int KROW = E_D; ArgsP a; int G;
    __device__ __forceinline__ void gap(int, bool, int) const {}
    __device__ __forceinline__ const char* abase(int) const { return (const char*)(a->ws + WS_H); }
    __device__ __forceinline__ const char* bbase(int) const { return (const char*)(a->ws + WS_WQ); }
    __device__ __forceinline__ void operator()(const f32x4 (&acc)[2][2][4][2], const UnitX& u, int wr, int wc, int fr, int fq) const { OPS_AP;
        if (u.g == 0) epi_b16(acc, u, wr, wc, fr, fq, (bf16_t*)(ap->ws + WS_H2), E_D, u.pn * BM, 1.0f);
        else epi_part(acc, u, wr, wc, fr, fq, (float*)(ap->ws + WS_ZSP)); }
};
template <class Ops, class Sched>
__device__ __forceinline__ void gemm_phase2(PG8_LAS unsigned char* lds, const Sched& S, const Ops& E, const bool skip_epi = false) {
    constexpr bool ALIGN_EPI = PG8_ALIGN_EPI, SP2 = PG8_SP2;
    const int tid = fresh_tid(), wid = __builtin_amdgcn_readfirstlane(tid >> 6), lane = tid & 63, wr = wid >> 2, wc = wid & 3, fr = lane & 15, fq = lane >> 4;
    constexpr int K = Ops::KROW;
    unsigned voffA[2], voffB[2];
#pragma unroll
    for (int i = 0; i < 2; ++i) { int R, C; stage_rc(tid * 16 + i * 8192, R, C); const int Rb = (R & ~31) + perm32(R & 31);
        voffA[i] = (unsigned)(R * K + C) * 2u; voffB[i] = (unsigned)(Rb * K + C) * 2u; }
    const size_t kstep = (size_t)(BK * 2);
    const size_t hstep = (size_t)HALF * K * 2;
    const size_t tstep = 2 * hstep;
    const unsigned ldsw = (unsigned)wid * 1024u;
    const int aoff = lds_byte(wr * 64 + fr, fq * 8), boff = lds_byte(wc * 32 + fr, fq * 8);
#define PG8_SA(b, h) (((b) * 2 + (h)) * HTB)
#define PG8_SB(b, h) ((4 + (b) * 2 + (h)) * HTB)
#define PG8_STAGE(bufoff, gbase, voff) do { _Pragma("unroll") for (int _i = 0; _i < 2; ++_i) \
        __builtin_amdgcn_global_load_lds((const unsigned*)((const char*)(gbase) + (voff)[_i]), (PG8_LAS unsigned*)(lds + (bufoff) + ldsw + _i * 8192), 16, 0, 0); } while (0)
#define PG8_LDA(dst, b, h) do { _Pragma("unroll") for (int m = 0; m < 4; ++m) _Pragma("unroll") for (int k = 0; k < 2; ++k) dst[m][k] = *(const PG8_LAS bf16x8*)(lds + PG8_SA(b, h) + aoff + m * 2048 + k * 1024); } while (0)
#define PG8_LDB(dst, b, h) do { _Pragma("unroll") for (int n = 0; n < 2; ++n) _Pragma("unroll") for (int k = 0; k < 2; ++k) dst[n][k] = *(const PG8_LAS bf16x8*)(lds + PG8_SB(b, h) + boff + n * 2048 + k * 1024); } while (0)
#define PG8_MMA(ai, bj, At, Bt) do { __builtin_amdgcn_s_setprio(1); _Pragma("unroll") for (int m = 0; m < 4; ++m) _Pragma("unroll") for (int n = 0; n < 2; ++n) _Pragma("unroll") for (int k = 0; k < 2; ++k) \
        acc[ai][bj][m][n] = __builtin_amdgcn_mfma_f32_16x16x32_bf16(Bt[n][k], At[m][k], acc[ai][bj][m][n], 0, 0, 0); __builtin_amdgcn_s_setprio(0); } while (0)
#define PG8_WAIT_V(n) asm volatile("s_waitcnt vmcnt(" #n ")" ::: "memory")
#define PG8_WAIT_L(n) asm volatile("s_waitcnt lgkmcnt(" #n ")" ::: "memory")
#define PG8_BAR __builtin_amdgcn_s_barrier()
#define PG8_SCHED __builtin_amdgcn_sched_barrier(0)
    UnitX cur, nxt; int ui = 0;
    if (!S.next(0, cur)) return;
    f32x4 acc[2][2][4][2];
#pragma unroll
    for (int a = 0; a < 2; ++a)
#pragma unroll
        for (int b = 0; b < 2; ++b)
#pragma unroll
            for (int m = 0; m < 4; ++m)
#pragma unroll
                for (int n = 0; n < 2; ++n) acc[a][b][m][n] = (f32x4){0.f, 0.f, 0.f, 0.f};
    bf16x8 At[4][2], B0[2][2], B1[2][2];
    const char* cA = E.abase(cur.g) + (size_t)cur.pm * tstep + (size_t)cur.kt0 * kstep; const char* cB = E.bbase(cur.g) + (size_t)cur.pn * tstep + (size_t)cur.kt0 * kstep;
    if constexpr (SP2) {
        PG8_STAGE(PG8_SB(0, 0), cB, voffB); PG8_STAGE(PG8_SB(0, 1), cB + hstep, voffB); PG8_STAGE(PG8_SA(0, 0), cA, voffA); PG8_STAGE(PG8_SA(0, 1), cA + hstep, voffA);
        if (wr == 1) PG8_BAR;
        PG8_WAIT_V(2); PG8_BAR;
        PG8_STAGE(PG8_SB(1, 0), cB + kstep, voffB); PG8_STAGE(PG8_SA(1, 0), cA + kstep, voffA); PG8_STAGE(PG8_SB(1, 1), cB + hstep + kstep, voffB);
        PG8_WAIT_V(6); PG8_BAR;
    } else {
        PG8_STAGE(PG8_SB(0, 0), cB, voffB); PG8_STAGE(PG8_SA(0, 0), cA, voffA); PG8_STAGE(PG8_SB(0, 1), cB + hstep, voffB); PG8_STAGE(PG8_SA(0, 1), cA + hstep, voffA);
        if (wr == 1) PG8_BAR;
        PG8_WAIT_V(4); PG8_BAR;
        PG8_STAGE(PG8_SB(1, 0), cB + kstep, voffB); PG8_STAGE(PG8_SA(1, 0), cA + kstep, voffA); PG8_STAGE(PG8_SB(1, 1), cB + hstep + kstep, voffB);
        PG8_WAIT_V(6); PG8_BAR;
    }
    for (;;) {
        const bool has_next = S.next(ui + 1, nxt);
        const char* nA = cA; const char* nB = cB; if (has_next) { nA = E.abase(nxt.g) + (size_t)nxt.pm * tstep + (size_t)nxt.kt0 * kstep; nB = E.bbase(nxt.g) + (size_t)nxt.pn * tstep + (size_t)nxt.kt0 * kstep; }
        const int nt = cur.nkt;
        for (int t = 0; t < nt; t += 2) {
            const bool last = (t == nt - 2);
            const char* a1 = cA + (size_t)(t + 1) * kstep;
            const char* a2 = last ? nA : cA + (size_t)(t + 2) * kstep; const char* b2 = last ? nB : cB + (size_t)(t + 2) * kstep;
            const char* a3 = a2 + kstep; const char* b3 = b2 + kstep;
            if constexpr (SP2) {
            PG8_LDB(B0, 0, 0); PG8_LDB(B1, 0, 1); PG8_SCHED; PG8_LDA(At, 0, 0); PG8_STAGE(PG8_SA(1, 1), a1 + hstep, voffA);
            PG8_WAIT_V(8); PG8_WAIT_L(0); PG8_BAR; PG8_MMA(0, 0, At, B0); PG8_MMA(0, 1, At, B1); PG8_BAR; PG8_SCHED;
            PG8_LDA(At, 0, 1); PG8_STAGE(PG8_SB(0, 0), b2, voffB); PG8_STAGE(PG8_SB(0, 1), b2 + hstep, voffB); PG8_STAGE(PG8_SA(0, 0), a2, voffA);
            PG8_WAIT_V(8); PG8_WAIT_L(0); PG8_BAR; PG8_MMA(1, 0, At, B0); PG8_MMA(1, 1, At, B1); PG8_BAR; PG8_SCHED;
            PG8_LDB(B0, 1, 0); PG8_LDB(B1, 1, 1); PG8_SCHED; PG8_LDA(At, 1, 0); PG8_STAGE(PG8_SA(0, 1), a2 + hstep, voffA);
            PG8_WAIT_V(8); PG8_WAIT_L(0); PG8_BAR; PG8_MMA(0, 0, At, B0); PG8_MMA(0, 1, At, B1); PG8_BAR; PG8_SCHED;
            PG8_LDA(At, 1, 1); PG8_STAGE(PG8_SB(1, 0), b3, voffB); PG8_STAGE(PG8_SB(1, 1), b3 + hstep, voffB); PG8_STAGE(PG8_SA(1, 0), a3, voffA);
            PG8_WAIT_V(8); PG8_WAIT_L(0); PG8_BAR; PG8_MMA(1, 0, At, B0); PG8_MMA(1, 1, At, B1); PG8_BAR; PG8_SCHED;
            } else {
            PG8_LDB(B0, 0, 0); PG8_SCHED; PG8_LDA(At, 0, 0); PG8_STAGE(PG8_SA(1, 1), a1 + hstep, voffA);
            PG8_WAIT_L(8); PG8_BAR; PG8_WAIT_L(0); PG8_MMA(0, 0, At, B0); PG8_BAR; PG8_SCHED;
            PG8_LDB(B1, 0, 1); PG8_STAGE(PG8_SB(0, 0), b2, voffB);
            PG8_BAR; PG8_WAIT_L(0); PG8_MMA(0, 1, At, B1); PG8_BAR;
            PG8_LDA(At, 0, 1); PG8_STAGE(PG8_SA(0, 0), a2, voffA);
            PG8_BAR; PG8_WAIT_L(0); PG8_MMA(1, 0, At, B0); PG8_BAR; PG8_SCHED;
            PG8_STAGE(PG8_SB(0, 1), b2 + hstep, voffB);
            PG8_WAIT_V(6); PG8_BAR; PG8_MMA(1, 1, At, B1); PG8_BAR;
            PG8_LDB(B0, 1, 0); PG8_SCHED; PG8_LDA(At, 1, 0); PG8_STAGE(PG8_SA(0, 1), a2 + hstep, voffA);
            PG8_WAIT_L(8); PG8_BAR; PG8_WAIT_L(0); PG8_MMA(0, 0, At, B0); PG8_BAR; PG8_SCHED;
            PG8_LDB(B1, 1, 1); PG8_STAGE(PG8_SB(1, 0), b3, voffB);
            PG8_BAR; PG8_WAIT_L(0); PG8_MMA(0, 1, At, B1); PG8_BAR;
            PG8_LDA(At, 1, 1); PG8_STAGE(PG8_SA(1, 0), a3, voffA);
            PG8_BAR; PG8_WAIT_L(0); PG8_MMA(1, 0, At, B0); PG8_BAR; PG8_SCHED;
            PG8_STAGE(PG8_SB(1, 1), b3 + hstep, voffB);
            PG8_WAIT_V(6); PG8_BAR; PG8_MMA(1, 1, At, B1); PG8_BAR;
            }
        }
        if constexpr (ALIGN_EPI) { if (wr == 0) PG8_BAR; }
        { int tid2; asm volatile("v_mov_b32 %0, %1" : "=v"(tid2) : "v"(tid));
            if (!skip_epi) E(acc, cur, wr, wc, tid2 & 15, (tid2 >> 4) & 3);
            else { _Pragma("unroll") for (int a_ = 0; a_ < 2; ++a_) _Pragma("unroll") for (int b_ = 0; b_ < 2; ++b_) _Pragma("unroll") for (int m_ = 0; m_ < 4; ++m_) _Pragma("unroll") for (int n_ = 0; n_ < 2; ++n_) asm volatile("" :: "v"(acc[a_][b_][m_][n_])); } }
        E.gap(ui, !has_next, tid);
        if (!has_next) break;
#pragma unroll
        for (int a = 0; a < 2; ++a)
#pragma unroll
            for (int b = 0; b < 2; ++b)
#pragma unroll
                for (int m = 0; m < 4; ++m)
#pragma unroll
                    for (int n = 0; n < 2; ++n) acc[a][b][m][n] = (f32x4){0.f, 0.f, 0.f, 0.f};
        cur = nxt; cA = nA; cB = nB; ++ui;
        if constexpr (ALIGN_EPI) { if (wr == 1) PG8_BAR; }
    }
    PG8_WAIT_V(0);
    if constexpr (!ALIGN_EPI) { if (wr == 0) PG8_BAR; }
    PG8_BAR;
#undef PG8_SA
#undef PG8_SB
#undef PG8_STAGE
#undef PG8_LDA
#undef PG8_LDB
#undef PG8_MMA
#undef PG8_WAIT_V
#undef PG8_WAIT_L
#undef PG8_BAR
#undef PG8_SCHED
}
}
#define XB_TMO      128
#define XB_XCNT(j)  (256  + 64 * (j))
#define XB_XSUB(j)  (1280 + 64 * (j))
#define XB_XGEN(j)  (2304 + 64 * (j))
#define XB_TOP      3328
#define XB_TOPGEN   3392
#define XCD_BAR_WORDS 3456
#define XB_SPIN_CAP (1u << 18)

__device__ __forceinline__ unsigned xb_ld(unsigned* p)              { return __hip_atomic_load(p, __ATOMIC_RELAXED, __HIP_MEMORY_SCOPE_AGENT); }
__device__ __forceinline__ unsigned xb_add(unsigned* p, unsigned v) { return __hip_atomic_fetch_add(p, v, __ATOMIC_RELAXED, __HIP_MEMORY_SCOPE_AGENT); }
__device__ __forceinline__ unsigned xb_xcc_id() { return (unsigned)__builtin_amdgcn_s_getreg((3 << 11) | 20) & 0xFu; }
#define XB_SPIN(cond, bar) do { unsigned _sp = 0; while (cond) { __builtin_amdgcn_s_sleep(1); \
    if ((++_sp & 255u) == 0u) { if (xb_ld(&(bar)[XB_TMO])) break; if (_sp > XB_SPIN_CAP) { atomicAdd(&(bar)[XB_TMO], 1u); break; } } } } while (0)

struct XcdBarrier {
    unsigned* bar; unsigned x;
    volatile LAS unsigned* st;
};

__device__ __forceinline__ XcdBarrier xcd_barrier_post(unsigned* bar, volatile LAS unsigned* st) {
    XcdBarrier b; b.bar = bar; b.x = xb_xcc_id(); b.st = st;
    if (threadIdx.x == 0) (void)xb_add(&bar[XB_XCNT(b.x)], 1u);
    return b;
}
__device__ __forceinline__ void xcd_barrier_complete(unsigned* bar, unsigned x, unsigned& nloc, unsigned& nx) {
    const unsigned G = gridDim.x * gridDim.y * gridDim.z;
    unsigned sum, cnt, mine, sp = 0u;
    for (;;) {
        sum = 0u; cnt = 0u; mine = 0u;
#pragma unroll
        for (unsigned j = 0; j < 16; ++j) { const unsigned c = xb_ld(&bar[XB_XCNT(j)]); sum += c; cnt += (c > 0u) ? 1u : 0u; mine = (j == x) ? c : mine; }
        if (sum == G) break;
        __builtin_amdgcn_s_sleep(1);
        if ((++sp & 255u) == 0u) { if (xb_ld(&bar[XB_TMO])) break; if (sp > XB_SPIN_CAP) { atomicAdd(&bar[XB_TMO], 1u); break; } }
    }
    nloc = mine > 0u ? mine : 1u; nx = cnt > 0u ? cnt : 1u;
}

__device__ __forceinline__ void xcd_barrier(const XcdBarrier& b) {
    asm volatile("s_waitcnt vmcnt(0)" ::: "memory");
    __syncthreads();
    if (threadIdx.x == 0) {
        unsigned* bar = b.bar;
        __builtin_amdgcn_s_waitcnt(0);
        unsigned nloc = b.st[0], nx = b.st[1];
        if (nloc == 0u) { xcd_barrier_complete(bar, b.x, nloc, nx); b.st[0] = nloc; b.st[1] = nx; }
        const unsigned old = xb_add(&bar[XB_XSUB(b.x)], 1u);
        const unsigned gen = old / nloc;
        if (old + 1u == (gen + 1u) * nloc) {
            __builtin_amdgcn_fence(__ATOMIC_RELEASE, "agent");
            asm volatile("s_waitcnt vmcnt(0)" ::: "memory");
            const unsigned og = xb_add(&bar[XB_TOP], 1u);
            const unsigned tg = og / nx;
            if (og + 1u == (tg + 1u) * nx) xb_add(&bar[XB_TOPGEN], 1u);
            else XB_SPIN(xb_ld(&bar[XB_TOPGEN]) == tg, bar);
            __builtin_amdgcn_fence(__ATOMIC_ACQUIRE, "agent");
            xb_add(&bar[XB_XGEN(b.x)], 1u);
            asm volatile("s_waitcnt vmcnt(0)" ::: "memory");
        } else {
            XB_SPIN(xb_ld(&bar[XB_XGEN(b.x)]) == gen, bar);
            __builtin_amdgcn_fence(__ATOMIC_ACQUIRE, "agent");
            asm volatile("s_waitcnt vmcnt(0)" ::: "memory");
        }
    }
    __syncthreads();
}
#ifndef ADA_DBN
#define ADA_DBN 16
#endif
#ifndef CV_KPAIR
#define CV_KPAIR 1
#endif
#ifndef ADA_DB
#define ADA_DB 1
#endif
#ifndef ADA_ILV
#define ADA_ILV 0
#endif
#ifndef ADA_UNR
#define ADA_UNR 8
#endif
#ifndef LN_SPRE
#define LN_SPRE 0
#endif
#ifndef LN_SREP
#define LN_SREP 1
#endif
#ifndef G2_SPLIT
#define G2_SPLIT 1
#endif
struct Frame {
    LAS unsigned char* lds;
    int vcu, G;
    ArgsP a;
};
#define F_IN(i) (F.a->in[i])
#define F_WS (F.a->ws)
#define F_OUT (F.a->out)
#define F_ADA ((float*)(F.a->ws + WS_ADA))
#define IN_XP 0
#define IN_XS 1
#define IN_STATE 2
#define IN_CK 3
#define IN_CV 4
#define IN_CP 5
#define IN_CS 6
#define IN_WADA 7
#define IN_BADA 8
#define IN_LNG 9
#define IN_LNB 10
#define IN_WUP 11
#define IN_WDN 12
#define IN_WAIN 13
#define IN_WGK2 14
#define IN_BGK 15
#define IN_GNORM 16
#define IN_WAOUT 17
#define IN_WADAKV 18
#define IN_BADAKV 19
#define IN_WKV 20
#define IN_WBQ 21
#define IN_REL 22
#define IN_WBO 23

struct TrItem { const float* W; bf16* WT; int ldw, ldt, kind, coff, k0, n0; };
__device__ __forceinline__ void tr_load(const TrItem& t, float (&v)[32], int lane) {
    const int nn = lane & 31; const int col = tr_nmap(t.kind, t.n0 + nn, t.coff);
#pragma unroll
    for (int i = 0; i < 32; ++i) { const int kk = 2 * i + (lane >> 5); v[i] = 0.f; if (col >= 0) v[i] = t.W[(size_t)tr_kmap(t.kind, t.k0 + kk) * t.ldw + col]; }
}
__device__ __forceinline__ void tr_store(const TrItem& t, const float (&v)[32], LAS float* scr, int lane) {
    const int nn = lane & 31;
#pragma unroll
    for (int i = 0; i < 32; ++i) { const int kk = 2 * i + (lane >> 5); scr[kk * 33 + nn] = v[i]; }
    LDS_WAIT(); asm volatile("" ::: "memory");
    const int c = lane & 7;
#pragma unroll
    for (int j = 0; j < 4; ++j) { const int n = (lane >> 3) + 8 * j; const LAS float* s = scr + (8 * c) * 33 + n;
        v4u o; o.x = pk2(s[0 * 33], s[1 * 33]); o.y = pk2(s[2 * 33], s[3 * 33]); o.z = pk2(s[4 * 33], s[5 * 33]); o.w = pk2(s[6 * 33], s[7 * 33]);
        st16_wt(t.WT + (size_t)(t.n0 + n) * t.ldt + t.k0 + 8 * c, o); }
    LDS_WAIT(); asm volatile("" ::: "memory");
}
__device__ __forceinline__ void p0_convert(Frame& F) {
    const int tid_ = fresh_tid(), lane_ = tid_ & 63, wave_ = __builtin_amdgcn_readfirstlane(tid_ >> 6); (void)lane_; (void)wave_;
    LAS float* scr = (LAS float*)(F.lds + wave_ * 16384);
    const int gw = F.vcu * NWAVES + wave_, NGW = F.G * NWAVES;
    constexpr int I_UP = 32 * 344, I_DN = 86 * 64, I_AN = 32 * 136, I_SQ = 32 * 64, I_CV = 8 * 64;
    constexpr int NITEMS = 4 * I_UP + 4 * I_DN + I_AN + 6 * I_SQ + 8 * I_CV;
    auto decode = [&](int it, TrItem& t) {
        unsigned char* ws = F_WS; int r = it; int nblk; t.kind = 0; t.coff = 0;
        if (r < 4 * I_UP) { const int m = r / I_UP; r -= m * I_UP; t.W = F_IN(IN_WUP) + (size_t)m * D * FF2; t.ldw = FF2; t.ldt = D; nblk = 344; t.kind = 1; t.WT = (bf16*)(ws + WS_WUP + (size_t)m * SZ_WUP); }
        else if ((r -= 4 * I_UP) < 4 * I_DN) { const int m = r / I_DN; r -= m * I_DN; t.W = F_IN(IN_WDN) + (size_t)m * FF * D; t.ldw = D; t.ldt = FF; nblk = 64; t.kind = 2; t.WT = (bf16*)(ws + WS_WDN + (size_t)m * SZ_WDN); }
        else if ((r -= 4 * I_DN) < I_AN) { t.W = F_IN(IN_WAIN); t.ldw = 6160; t.ldt = D; nblk = 136; t.kind = 3; t.WT = (bf16*)(ws + WS_WAN); }
        else if ((r -= I_AN) < I_SQ) { t.W = F_IN(IN_WAIN); t.ldw = 6160; t.ldt = D; nblk = 64; t.coff = 2048; t.WT = (bf16*)(ws + WS_WAV); }
        else if ((r -= I_SQ) < I_SQ) { t.W = F_IN(IN_WAOUT); t.ldw = D; t.ldt = D; nblk = 64; t.WT = (bf16*)(ws + WS_WAO); }
        else if ((r -= I_SQ) < I_SQ) { t.W = F_IN(IN_WKV); t.ldw = 2 * D; t.ldt = D; nblk = 64; t.WT = (bf16*)(ws + WS_WK); }
        else if ((r -= I_SQ) < I_SQ) { t.W = F_IN(IN_WKV); t.ldw = 2 * D; t.ldt = D; nblk = 64; t.coff = D; t.WT = (bf16*)(ws + WS_WV); }
        else if ((r -= I_SQ) < I_SQ) { t.W = F_IN(IN_WBQ); t.ldw = D; t.ldt = D; nblk = 64; t.WT = (bf16*)(ws + WS_WQ); }
        else if ((r -= I_SQ) < I_SQ) { t.W = F_IN(IN_WBO); t.ldw = D; t.ldt = D; nblk = 64; t.WT = (bf16*)(ws + WS_WBO); }
        else { r -= I_SQ; const int b = r / I_CV; r -= b * I_CV; t.W = F_IN(IN_CV) + (size_t)b * 512 * D; t.ldw = D; t.ldt = 512; nblk = 64; t.WT = (bf16*)(ws + WS_VTC + (size_t)b * 2048 * 512 * 2); }
#if CV_KPAIR
        const int gsh_ = (CV_KPAIR == 2 && t.kind != 2) ? 2 : 1;
        const int q_ = r >> gsh_, kq_ = q_ / nblk; const int kb = (kq_ << gsh_) + (r & ((1 << gsh_) - 1)); t.k0 = 64 * kb; t.n0 = 32 * (q_ - kq_ * nblk);
#else
        const int kb = r / nblk; t.k0 = 64 * kb; t.n0 = 32 * (r - kb * nblk);
#endif
    };
    TrItem ta, tb; float va[32], vb[32];
    int it = gw;
    if (it < NITEMS) { decode(it, ta); tr_load(ta, va, lane_); }
    while (it < NITEMS) {
        const int i1 = it + NGW, i2 = it + 2 * NGW;
        if (i1 < NITEMS) { decode(i1, tb); tr_load(tb, vb, lane_); }
        tr_store(ta, va, scr, lane_);
        if (i1 >= NITEMS) break;
        if (i2 < NITEMS) { decode(i2, ta); tr_load(ta, va, lane_); }
        tr_store(tb, vb, scr, lane_);
        it = i2;
    }
}
__device__ __forceinline__ void p0_ada(Frame& F) {
    const int tid_ = fresh_tid(), lane_ = tid_ & 63, wave_ = __builtin_amdgcn_readfirstlane(tid_ >> 6); (void)lane_; (void)wave_;
    LAS float* cs = (LAS float*)F.lds;
    LAS float* red = (LAS float*)(F.lds + 73728);
    const int NIT = 256;
    if (F.vcu >= NIT) return;
    for (int i = tid_; i < 9 * D; i += NWAVES * 64) { const int ci = i >> 11, k = i & 2047; const float c = ci == 0 ? F_IN(IN_CP)[k] : F_IN(IN_CS)[(size_t)(ci - 1) * D + k]; cs[i] = silu(c); }
    __syncthreads();
    for (int it = F.vcu; it < NIT; it += F.G) {
        const int mat = it < 115 ? 0 : (it < 230 ? 1 : 2); const int j = it - mat * 115;
        const float* W = mat < 2 ? F_IN(IN_WADA) + (size_t)mat * D * 18432 : F_IN(IN_WADAKV); const int ldw = mat < 2 ? 18432 : 4096;
        const float* bias = mat < 2 ? F_IN(IN_BADA) + (size_t)mat * 18432 : F_IN(IN_BADAKV);
        const int start4 = mat < 2 ? (j < 8 ? 41 * j : 328 + 40 * (j - 8)) : (j < 10 ? 40 * j : 400 + 39 * (j - 10));
        const int n4 = mat < 2 ? (j < 8 ? 41 : 40) : (j < 10 ? 40 : 39);
        const int c0 = 4 * start4, ncol = 4 * n4, ocol = mat * 18432 + c0;
        const bool on = lane_ < n4;
        f32x4 acc[9];
#pragma unroll
        for (int ci = 0; ci < 9; ++ci) acc[ci] = (f32x4){0.f, 0.f, 0.f, 0.f};
#if ADA_ILV
        const float* wp = W + (size_t)wave_ * ldw + c0 + 4 * (on ? lane_ : 0);
#else
        const float* wp = W + (size_t)(wave_ * 256) * ldw + c0 + 4 * (on ? lane_ : 0);
#endif
#if ADA_DB
#define ADA_LOAD(R, kb_) do { _Pragma("unroll") for (int k = 0; k < ADA_DBN; ++k) R[k] = *(const f32x4*)(wp + (size_t)((kb_) + k) * (ADA_ILV ? 8 : 1) * ldw); } while (0)
#define ADA_ACC(R, kb_) do { _Pragma("unroll") for (int k = 0; k < ADA_DBN; ++k) { _Pragma("unroll") for (int ci = 0; ci < 9; ++ci) { const float c = cs[ci * D + (ADA_ILV ? 8 * ((kb_) + k) + wave_ : wave_ * 256 + (kb_) + k)]; acc[ci] += R[k] * c; } \
            asm volatile("" ::: "memory"); } } while (0)
        f32x4 wa[ADA_DBN], wb[ADA_DBN];
        ADA_LOAD(wa, 0);
#pragma unroll 1
        for (int kb = 0; kb < 256; kb += 2 * ADA_DBN) {
            ADA_LOAD(wb, kb + ADA_DBN);
            ADA_ACC(wa, kb);
            ADA_LOAD(wa, kb + 2 * ADA_DBN < 256 ? kb + 2 * ADA_DBN : 256 - ADA_DBN);
            ADA_ACC(wb, kb + ADA_DBN);
        }
#undef ADA_LOAD
#undef ADA_ACC
#else
#pragma unroll 1
        for (int kb = 0; kb < 256; kb += ADA_UNR) {
            f32x4 wv[ADA_UNR];
#pragma unroll
            for (int k = 0; k < ADA_UNR; ++k) wv[k] = *(const f32x4*)(wp + (size_t)(kb + k) * (ADA_ILV ? 8 : 1) * ldw);
#pragma unroll
            for (int k = 0; k < ADA_UNR; ++k) {
#pragma unroll
                for (int ci = 0; ci < 9; ++ci) { const float c = cs[ci * D + (ADA_ILV ? 8 * (kb + k) + wave_ : wave_ * 256 + kb + k)]; acc[ci] += wv[k] * c; }
                asm volatile("" ::: "memory");
            }
        }
#endif
        if (on) {
#pragma unroll
            for (int ci = 0; ci < 9; ++ci) *(LAS f32x4*)(red + (wave_ * 9 + ci) * 164 + 4 * lane_) = acc[ci];
        }
        __syncthreads();
        for (int o = tid_; o < 9 * 164; o += NWAVES * 64) { const int ci = o / 164, c = o - ci * 164;
            if (c < ncol) { float s = bias[c0 + c];
#pragma unroll
                for (int w = 0; w < 8; ++w) s += red[(w * 9 + ci) * 164 + c];
                F_ADA[(size_t)ci * ADA_LD + ocol + c] = s; } }
        __syncthreads();
    }
}
constexpr __host__ __device__ int ada_off(int l, int s, int kind) { return l * 18432 + s * 6144 + kind * 2048; }
constexpr int ADA_KV_SHIFT = 36864, ADA_KV_SCALE = 36864 + 2048;
__device__ __forceinline__ void mod0_phase(Frame& F) {
    const int tid_ = fresh_tid(), lane_ = tid_ & 63, wave_ = __builtin_amdgcn_readfirstlane(tid_ >> 6); (void)lane_; (void)wave_;
    const int gw = F.vcu * NWAVES + wave_, NGW = F.G * NWAVES;
    bf16* H = (bf16*)(F_WS + WS_H);
    const int osh = ada_off(0, 0, 0), osc = ada_off(0, 0, 1);
    for (int row = gw; row < MP; row += NGW) {
        v2u* hr = (v2u*)(H + (size_t)row * D) + lane_;
        if (row >= MR) {
#pragma unroll
            for (int j = 0; j < 8; ++j) hr[64 * j] = (v2u){0u, 0u};
            continue;
        }
        const int ci = row < TP ? 0 : 1 + ((row - TP) >> 4);
        const float* xr = row < TP ? F_IN(IN_XP) + (size_t)row * D : F_IN(IN_XS) + (size_t)(row - TP) * D;
        const f32x4* x4 = (const f32x4*)xr + lane_; const f32x4* sh4 = (const f32x4*)(F_ADA + (size_t)ci * ADA_LD + osh) + lane_; const f32x4* sc4 = (const f32x4*)(F_ADA + (size_t)ci * ADA_LD + osc) + lane_;
#pragma unroll
        for (int j = 0; j < 8; ++j) { const f32x4 x = x4[64 * j], sh = sh4[64 * j], sc = sc4[64 * j]; const f32x4 h = x * (sc + 1.0f) + sh;
            hr[64 * j] = (v2u){pk2(h.x, h.y), pk2(h.z, h.w)}; }
    }
}
template <int SUB>
__device__ __forceinline__ void ln_phase(Frame& F, int osh1, int osc1, bf16* H1, int osh2, int osc2, bf16* H2o, int goff, float gs, int npcs) {
    const int tid_ = fresh_tid(), lane_ = tid_ & 63, wave_ = __builtin_amdgcn_readfirstlane(tid_ >> 6); (void)lane_; (void)wave_;
    const int gw = F.vcu * NWAVES + wave_, NGW = F.G * NWAVES;
    constexpr bool LAST = SUB == 5;
    const float* g = F_IN(IN_LNG) + SUB * D; const float* b = F_IN(IN_LNB) + SUB * D;
    auto finish = [&](int row, int ci, f32x4 (&v)[8], float* xo, bool stat) {
        float s = 0.f;
#pragma unroll
        for (int j = 0; j < 8; ++j) s += (v[j].x + v[j].y) + (v[j].z + v[j].w);
        const float mean = wave_sum(s) * (1.0f / D); float s2 = 0.f;
#pragma unroll
        for (int j = 0; j < 8; ++j) { v[j] = v[j] - mean; s2 += (v[j].x * v[j].x + v[j].y * v[j].y) + (v[j].z * v[j].z + v[j].w * v[j].w); }
        const float rstd = 1.0f / sqrtf(wave_sum(s2) * (1.0f / D) + LN_EPS);
        if (stat && lane_ == 0) *(f32x2v*)((float*)(F_WS + WS_STAT) + 2 * (size_t)row) = (f32x2v){mean, rstd};
#pragma unroll
        for (int j = 0; j < 4; ++j) { const int c = 8 * lane_ + 512 * j;
            v[2 * j] = v[2 * j] * rstd * *(const f32x4*)(g + c) + *(const f32x4*)(b + c); v[2 * j + 1] = v[2 * j + 1] * rstd * *(const f32x4*)(g + c + 4) + *(const f32x4*)(b + c + 4);
            if (xo) { *(f32x4*)(xo + c) = v[2 * j]; *(f32x4*)(xo + c + 4) = v[2 * j + 1]; } }
        const float* ar = F_ADA + (size_t)ci * ADA_LD;
        if (H1) {
#pragma unroll
            for (int j = 0; j < 4; ++j) { const int c = 8 * lane_ + 512 * j;
                const f32x4 h0 = v[2 * j] * (*(const f32x4*)(ar + osc1 + c) + 1.0f) + *(const f32x4*)(ar + osh1 + c), h1 = v[2 * j + 1] * (*(const f32x4*)(ar + osc1 + c + 4) + 1.0f) + *(const f32x4*)(ar + osh1 + c + 4);
                st16_wt(H1 + (size_t)row * D + c, (v4u){pk2(h0.x, h0.y), pk2(h0.z, h0.w), pk2(h1.x, h1.y), pk2(h1.z, h1.w)}); } }
        if (H2o) {
#pragma unroll
            for (int j = 0; j < 4; ++j) { const int c = 8 * lane_ + 512 * j;
                const f32x4 h0 = v[2 * j] * (*(const f32x4*)(ar + osc2 + c) + 1.0f) + *(const f32x4*)(ar + osh2 + c), h1 = v[2 * j + 1] * (*(const f32x4*)(ar + osc2 + c + 4) + 1.0f) + *(const f32x4*)(ar + osh2 + c + 4);
                st16_wt(H2o + (size_t)row * D + c, (v4u){pk2(h0.x, h0.y), pk2(h0.z, h0.w), pk2(h1.x, h1.y), pk2(h1.z, h1.w)}); } }
    };
    f32x4 t[21], xv = {0.f, 0.f, 0.f, 0.f}, gv = {0.f, 0.f, 0.f, 0.f};
#pragma unroll
    for (int pc = 0; pc < 21; ++pc) t[pc] = (f32x4){0.f, 0.f, 0.f, 0.f};
    if (LN_SPRE && F.vcu < 128) {
        const int r = F.vcu, c0 = 256 * wave_ + 4 * lane_;
        const float* zp = (const float*)(F_WS + WS_ZSP) + (size_t)r * D + c0;
#pragma unroll
        for (int pc = 0; pc < 21; ++pc) if (pc < npcs) t[pc] = *(const f32x4*)(zp + (size_t)pc * 128 * D);
        xv = *(const f32x4*)((SUB == 0 ? F_IN(IN_XS) + (size_t)r * D : (const float*)(F_WS + WS_XS) + (size_t)r * D) + c0);
        gv = *(const f32x4*)(F_ADA + (size_t)(1 + (r >> 4)) * ADA_LD + goff + c0);
    }
    {
        const bf16* Zb = (const bf16*)(F_WS + ((SUB & 1) ? WS_ZB1 : WS_ZB0));
        v4u nx[4];
        if (gw < TP) {
#pragma unroll
            for (int j = 0; j < 4; ++j) nx[j] = *(const v4u*)(Zb + (size_t)gw * D + 8 * lane_ + 512 * j); }
        for (int row = gw; row < TP; row += NGW) {
            f32x4 v[8];
#pragma unroll
            for (int j = 0; j < 4; ++j) { const v4u w = nx[j];
                v[2 * j] = (f32x4){__uint_as_float(w.x << 16), __uint_as_float(w.x & 0xffff0000u), __uint_as_float(w.y << 16), __uint_as_float(w.y & 0xffff0000u)};
                v[2 * j + 1] = (f32x4){__uint_as_float(w.z << 16), __uint_as_float(w.z & 0xffff0000u), __uint_as_float(w.w << 16), __uint_as_float(w.w & 0xffff0000u)}; }
            if (row + NGW < TP) {
#pragma unroll
                for (int j = 0; j < 4; ++j) nx[j] = *(const v4u*)(Zb + (size_t)(row + NGW) * D + 8 * lane_ + 512 * j); }
            finish(row, 0, v, LAST ? F_OUT + O_YP + (size_t)row * D : nullptr, !LAST);
        }
    }
    for (int rr = F.vcu; rr < 256; rr += F.G) {
    for (int srep_ = 0; srep_ < LN_SREP; ++srep_) {
    asm volatile("" ::: "memory");
    __syncthreads();
    if (rr < 128) {
        LAS float* red = (LAS float*)F.lds;
        const int r = rr, row = TP + r, ci = 1 + (r >> 4), c0 = 256 * wave_ + 4 * lane_;
        const float* zp = (const float*)(F_WS + WS_ZSP) + (size_t)r * D + c0;
        float* xs = (float*)(F_WS + WS_XS) + (size_t)r * D;
        const float* ar = F_ADA + (size_t)ci * ADA_LD;
        if (!(LN_SPRE && rr == F.vcu && srep_ == 0)) {
#pragma unroll
            for (int pc = 0; pc < 21; ++pc) if (pc < npcs) t[pc] = *(const f32x4*)(zp + (size_t)pc * 128 * D);
            xv = *(const f32x4*)((SUB == 0 ? F_IN(IN_XS) + (size_t)r * D : (const float*)xs) + c0);
            gv = *(const f32x4*)(ar + goff + c0);
        }
        f32x4 v = t[0];
#pragma unroll
        for (int pc = 1; pc < 21; ++pc) if (pc < npcs) v += t[pc];
        v = xv * 1.41421356237309515f + (gv + 1.0f) * (v * gs);
        const float s = wave_sum((v.x + v.y) + (v.z + v.w));
        if (lane_ == 0) red[wave_] = s;
        __syncthreads();
        float tot = 0.f;
#pragma unroll
        for (int w = 0; w < 8; ++w) tot += red[w];
        const float mean = tot * (1.0f / D);
        v = v - mean;
        const float s2 = wave_sum((v.x * v.x + v.y * v.y) + (v.z * v.z + v.w * v.w));
        if (lane_ == 0) red[8 + wave_] = s2;
        __syncthreads();
        float tot2 = 0.f;
#pragma unroll
        for (int w = 0; w < 8; ++w) tot2 += red[8 + w];
        const float rstd = 1.0f / sqrtf(tot2 * (1.0f / D) + LN_EPS);
        v = v * rstd * *(const f32x4*)(g + c0) + *(const f32x4*)(b + c0);
        if (srep_ == LN_SREP - 1) *(f32x4*)((LAST ? F_OUT + O_YS + (size_t)r * D : xs) + c0) = v;
        if (H1) { const f32x4 h = v * (*(const f32x4*)(ar + osc1 + c0) + 1.0f) + *(const f32x4*)(ar + osh1 + c0); *(v2u*)(H1 + (size_t)row * D + c0) = (v2u){pk2(h.x, h.y), pk2(h.z, h.w)}; }
        if (H2o) { const f32x4 h = v * (*(const f32x4*)(ar + osc2 + c0) + 1.0f) + *(const f32x4*)(ar + osh2 + c0); *(v2u*)(H2o + (size_t)row * D + c0) = (v2u){pk2(h.x, h.y), pk2(h.z, h.w)}; }
    } else {
        const int row = MR + (rr - 128), c0 = 256 * wave_ + 4 * lane_;
        if (H1) *(v2u*)(H1 + (size_t)row * D + c0) = (v2u){0u, 0u};
        if (H2o) *(v2u*)(H2o + (size_t)row * D + c0) = (v2u){0u, 0u};
    }
    }
    }
}
__device__ __forceinline__ float logsigmoid_f(float x) { return fminf(x, 0.f) - __logf(1.0f + __expf(-fabsf(x))); }
__device__ __forceinline__ void gla_g2_phase(Frame& F, int u0, int u1, int ustart, int ustep) {
    const int tid_ = fresh_tid(), lane_ = tid_ & 63, wave_ = __builtin_amdgcn_readfirstlane(tid_ >> 6); (void)lane_; (void)wave_;
    constexpr int LDQ = 264;
    LAS bf16* QTs = (LAS bf16*)F.lds; LAS bf16* KTs = (LAS bf16*)(F.lds + 64 * LDQ * 2); LAS float* GL = (LAS float*)(F.lds + 2 * 64 * LDQ * 2);
    LAS float* BBs = (LAS float*)(F.lds + 2 * 64 * LDQ * 2 + 4096);
    LAS float* HS = (LAS float*)(F.lds + 2 * 64 * LDQ * 2 + 4096 + 65536);
    static_assert(2 * 64 * LDQ * 2 + 4096 + 65536 + 2048 <= LDSCTL_OFF, "G2 LDS");
    const bf16* Qg = (const bf16*)(F_WS + WS_QG); const bf16* Kg = (const bf16*)(F_WS + WS_KG); const float* GKL = (const float*)(F_WS + WS_GKL);
    bf16* QT = (bf16*)(F_WS + WS_QT); bf16* KDT = (bf16*)(F_WS + WS_KDT); bf16* P = (bf16*)(F_WS + WS_P); float* DEC = (float*)(F_WS + WS_DEC);
    const int fr = lane_ & 15, fq = lane_ >> 4;
    for (int unit = u0 + ustart; unit < u1; unit += ustep) {
        const int ch = unit >> 2, h = unit & 3;
        const int nrows = ch < 256 ? 64 : 16, row0 = ch < 256 ? ch * 64 : TP + (ch - 256) * 16;
#pragma unroll
        for (int i = 0; i < 4; ++i) { const int idx = tid_ + 512 * i, j = idx >> 5, seg = idx & 31; v4u qv = {0u, 0u, 0u, 0u}, kv = {0u, 0u, 0u, 0u};
            if (j < nrows) { qv = *(const v4u*)(Qg + (size_t)(row0 + j) * 1024 + h * 256 + seg * 8); kv = *(const v4u*)(Kg + (size_t)(row0 + j) * 1024 + h * 256 + seg * 8); }
            *(LAS v4u*)(QTs + j * LDQ + seg * 8) = qv; *(LAS v4u*)(KTs + j * LDQ + seg * 8) = kv; }
        if (tid_ < 256) { const int j = tid_ >> 2, q4 = tid_ & 3; f32x4 v = {0.f, 0.f, 0.f, 0.f}; if (j < nrows) v = *(const f32x4*)(GKL + (size_t)(row0 + j) * 16 + 4 * q4); *(LAS f32x4*)(GL + j * 16 + 4 * q4) = v; }
        __syncthreads();
        const int c = tid_ & 255, jh = tid_ >> 8, col = h * 256 + c, j0 = 32 * jh;
        {
            float w2[16];
#pragma unroll
            for (int r = 0; r < 16; ++r) w2[r] = F_IN(IN_WGK2)[r * 1024 + col];
            const float bias = F_IN(IN_BGK)[col];
            float sum = 0.f;
#pragma unroll 4
            for (int jj = 0; jj < 32; ++jj) { const int j = j0 + jj; float la = 0.f;
                if (j < nrows) { float x = bias;
#pragma unroll
                    for (int r4 = 0; r4 < 4; ++r4) { const f32x4 g = *(const LAS f32x4*)(GL + j * 16 + 4 * r4); x += g.x * w2[4 * r4] + g.y * w2[4 * r4 + 1] + g.z * w2[4 * r4 + 2] + g.w * w2[4 * r4 + 3]; }
                    la = logsigmoid_f(x) * 0.0625f; }
                BBs[j * 256 + c] = la; sum += la; }
            HS[jh * 256 + c] = sum;
        }
        __syncthreads();
        {
            const float h0 = HS[c], blast = h0 + HS[256 + c];
            float b = jh ? h0 : 0.f;
            bf16* qt_g = QT + ((size_t)unit * 64 + j0) * 256 + c;
            bf16* kd_g = KDT + ((size_t)unit * 256 + c) * 64 + j0;
            if (jh == 0) DEC[(size_t)unit * 256 + c] = __expf(blast);
#pragma unroll 1
            for (int j8 = 0; j8 < 4; ++j8) {
                float kd[8];
                if (j0 + j8 * 8 < nrows) {
#pragma unroll
                for (int e = 0; e < 8; ++e) { const int j = j0 + j8 * 8 + e;
                    b += BBs[j * 256 + c];
                    const float qv = bf2f(QTs[j * LDQ + c]), kv = bf2f(KTs[j * LDQ + c]);
                    const unsigned short qb = (unsigned short)f2bf(qv * __expf(b)), kb = (unsigned short)f2bf(kv * __expf(-b));
                    QTs[j * LDQ + c] = qb; KTs[j * LDQ + c] = kb; qt_g[(size_t)(j8 * 8 + e) * 256] = qb;
                    kd[e] = kv * __expf(blast - b); }
                } else {
#pragma unroll
                for (int e = 0; e < 8; ++e) { qt_g[(size_t)(j8 * 8 + e) * 256] = 0; kd[e] = 0.f; }
                }
                v4u o; o.x = pk2(kd[0], kd[1]); o.y = pk2(kd[2], kd[3]); o.z = pk2(kd[4], kd[5]); o.w = pk2(kd[6], kd[7]);
                *(v4u*)(kd_g + j8 * 8) = o;
            }
        }
        __syncthreads();
        {
            const int mi = wave_ & 3, nb = 2 * (wave_ >> 2);
            f32x4 acc0 = {0.f, 0.f, 0.f, 0.f}, acc1 = {0.f, 0.f, 0.f, 0.f};
#pragma unroll
            for (int s = 0; s < 8; ++s) {
                const bf16x8 a = *(const LAS bf16x8*)(QTs + (mi * 16 + fr) * LDQ + s * 32 + fq * 8);
                const bf16x8 b0 = *(const LAS bf16x8*)(KTs + (nb * 16 + fr) * LDQ + s * 32 + fq * 8);
                const bf16x8 b1 = *(const LAS bf16x8*)(KTs + (nb * 16 + 16 + fr) * LDQ + s * 32 + fq * 8);
                acc0 = MFMA16(b0, a, acc0); acc1 = MFMA16(b1, a, acc1);
            }
            const int i = mi * 16 + fr; bf16* pr = P + ((size_t)unit * 64 + i) * 64;
#pragma unroll
            for (int t = 0; t < 2; ++t) { const f32x4 a = t ? acc1 : acc0; const int jc = (nb + t) * 16 + 4 * fq;
                const float p0 = jc + 0 <= i ? a[0] : 0.f, p1 = jc + 1 <= i ? a[1] : 0.f, p2 = jc + 2 <= i ? a[2] : 0.f, p3 = jc + 3 <= i ? a[3] : 0.f;
                *(v2u*)(pr + jc) = (v2u){pk2(p0, p1), pk2(p2, p3)}; }
        }
        __syncthreads();
    }
}
constexpr size_t WS_SL = WS_UT, WS_GD = WS_SL + (size_t)16 * 4 * 256 * 512 * 4, WS_OB = WS_GD + (size_t)16 * 4 * 256 * 4;
static_assert(WS_OB + SZ_B16ACT <= WS_GLA_END && WS_GD % 256 == 0 && WS_OB % 256 == 0, "GLA recurrence workspace");
constexpr int GL_KDP = 144, GL_QTP = 528, GL_PP = 144;
constexpr int GL_KD = 0, GL_QT = GL_KD + 256 * GL_KDP, GL_P = GL_QT + 64 * GL_QTP, GL_DEC = GL_P + 64 * GL_PP, GL_END = GL_DEC + 1024;
static_assert(GL_END <= LDSCTL_OFF, "GLA LDS");
template <bool WITH_O>
__device__ __forceinline__ void gla_unit(Frame& F, f32x4 (&S)[16], int ch0, int nc, int h, int slice, int tok0, int tokstep, int nrows_o, int tid_, int wave_, int fr, int fq) {
    const bf16* VT = (const bf16*)(F_WS + WS_VTG); const bf16* KDT = (const bf16*)(F_WS + WS_KDT); const bf16* QT = (const bf16*)(F_WS + WS_QT); const bf16* P = (const bf16*)(F_WS + WS_P);
    const float* DEC = (const float*)(F_WS + WS_DEC); bf16* OB = (bf16*)(F_WS + WS_OB);
    LAS unsigned char* KDs = F.lds + GL_KD; LAS unsigned char* QTs = F.lds + GL_QT; LAS unsigned char* Ps = F.lds + GL_P; LAS float* DECs = (LAS float*)(F.lds + GL_DEC);
    const int vc = slice * 128 + wave_ * 16 + fr;
    const bf16* vtp = VT + (size_t)(h * 512 + vc) * MP + tok0 + 8 * fq;
    v4u rk[4], rq[4], rp; f32x4 rd;
#define GL_LOAD(ch) do { const size_t u_ = (size_t)(ch) * 4 + h; \
        _Pragma("unroll") for (int i_ = 0; i_ < 4; ++i_) { const int idx_ = tid_ + 512 * i_; rk[i_] = *(const v4u*)(KDT + (u_ * 256 + (idx_ >> 3)) * 64 + (idx_ & 7) * 8); } \
        if (WITH_O) { _Pragma("unroll") for (int i_ = 0; i_ < 4; ++i_) { const int idx_ = tid_ + 512 * i_; rq[i_] = *(const v4u*)(QT + (u_ * 64 + (idx_ >> 5)) * 256 + (idx_ & 31) * 8); } \
                      rp = *(const v4u*)(P + (u_ * 64 + (tid_ >> 3)) * 64 + (tid_ & 7) * 8); } \
        if (tid_ < 64) rd = *(const f32x4*)(DEC + u_ * 256 + 4 * tid_); } while (0)
#define GL_STORE() do { \
        _Pragma("unroll") for (int i_ = 0; i_ < 4; ++i_) { const int idx_ = tid_ + 512 * i_; *(LAS v4u*)(KDs + (idx_ >> 3) * GL_KDP + (idx_ & 7) * 16) = rk[i_]; } \
        if (WITH_O) { _Pragma("unroll") for (int i_ = 0; i_ < 4; ++i_) { const int idx_ = tid_ + 512 * i_; *(LAS v4u*)(QTs + (idx_ >> 5) * GL_QTP + (idx_ & 31) * 16) = rq[i_]; } \
                      *(LAS v4u*)(Ps + (tid_ >> 3) * GL_PP + (tid_ & 7) * 16) = rp; } \
        if (tid_ < 64) *(LAS f32x4*)(DECs + 4 * tid_) = rd; } while (0)
    GL_LOAD(ch0);
    for (int c = 0; c < nc; ++c) {
        GL_STORE();
        __syncthreads();
        if (c + 1 < nc) GL_LOAD(ch0 + c + 1);
        const bf16* vt = vtp + (size_t)c * tokstep;
        const bf16x8 vb0 = *(const bf16x8*)vt, vb1 = *(const bf16x8*)(vt + 32);
        if (WITH_O) {
            f32x4 o[4];
#pragma unroll
            for (int m2 = 0; m2 < 4; ++m2) o[m2] = (f32x4){0.f, 0.f, 0.f, 0.f};
#pragma unroll
            for (int ks = 0; ks < 8; ++ks) {
                const v4u sw = {pk2(S[2 * ks][0], S[2 * ks][1]), pk2(S[2 * ks][2], S[2 * ks][3]), pk2(S[2 * ks + 1][0], S[2 * ks + 1][1]), pk2(S[2 * ks + 1][2], S[2 * ks + 1][3])};
                const bf16x8 sb = __builtin_bit_cast(bf16x8, sw);
#pragma unroll
                for (int m2 = 0; m2 < 4; ++m2) {
                    LAS unsigned char* qp = QTs + (16 * m2 + fr) * GL_QTP + ks * 64 + fq * 8;
                    const v2u qlo = *(const LAS v2u*)qp, qhi = *(const LAS v2u*)(qp + 32);
                    const v4u qw = {qlo.x, qlo.y, qhi.x, qhi.y};
                    o[m2] = MFMA16(__builtin_bit_cast(bf16x8, qw), sb, o[m2]);
                }
                __builtin_amdgcn_sched_barrier(0);
            }
#pragma unroll
            for (int m2 = 0; m2 < 4; ++m2) {
                LAS unsigned char* pp = Ps + (16 * m2 + fr) * GL_PP + fq * 16;
                o[m2] = MFMA16(*(const LAS bf16x8*)pp, vb0, o[m2]);
                o[m2] = MFMA16(*(const LAS bf16x8*)(pp + 64), vb1, o[m2]);
            }
            bf16* obu = OB + ((size_t)tok0 + (size_t)c * tokstep) * D + h * 512;
            const unsigned olo = (unsigned)(4 * fq) * D + (unsigned)vc;
#pragma unroll
            for (int m2 = 0; m2 < 4; ++m2)
#pragma unroll
                for (int j = 0; j < 4; ++j) { const int i = 16 * m2 + 4 * fq + j; if (i < nrows_o) (obu + (size_t)(16 * m2 + j) * D)[olo] = (bf16)f2bf(o[m2][j]); }
        }
#pragma unroll
        for (int mi = 0; mi < 16; ++mi) {
            const f32x4 d4 = *(const LAS f32x4*)(DECs + 16 * mi + 4 * fq);
            LAS unsigned char* kp = KDs + (16 * mi + fr) * GL_KDP + fq * 16;
            const bf16x8 a0 = *(const LAS bf16x8*)kp, a1 = *(const LAS bf16x8*)(kp + 64);
            S[mi] = S[mi] * d4;
            S[mi] = MFMA16(a0, vb0, S[mi]);
            S[mi] = MFMA16(a1, vb1, S[mi]);
            if (mi & 1) __builtin_amdgcn_sched_barrier(0);
        }
        __syncthreads();
    }
#undef GL_LOAD
#undef GL_STORE
}
__device__ __forceinline__ void gla_pass1_phase(Frame& F) {
    const int tid_ = fresh_tid(), lane_ = tid_ & 63, wave_ = __builtin_amdgcn_readfirstlane(tid_ >> 6);
    const int fr = lane_ & 15, fq = lane_ >> 4;
    float* SL = (float*)(F_WS + WS_SL); float* GD = (float*)(F_WS + WS_GD); const float* DEC = (const float*)(F_WS + WS_DEC);
    for (int id = F.vcu; id < 15 * 16; id += F.G) {
        const int g = id >> 4, h = (id >> 2) & 3, slice = id & 3;
        f32x4 S[16];
#pragma unroll
        for (int mi = 0; mi < 16; ++mi) S[mi] = (f32x4){0.f, 0.f, 0.f, 0.f};
        gla_unit<false>(F, S, 16 * g, 16, h, slice, 16 * g * 64, 64, 0, tid_, wave_, fr, fq);
        const int vc = slice * 128 + wave_ * 16 + fr;
        float* slu = SL + (size_t)(g * 4 + h) * 256 * 512; const unsigned slo = (unsigned)(4 * fq) * 512 + (unsigned)vc;
#pragma unroll
        for (int mi = 0; mi < 16; ++mi)
#pragma unroll
            for (int j = 0; j < 4; ++j) (slu + (size_t)(16 * mi + j) * 512)[slo] = S[mi][j];
        if (slice == 0 && tid_ < 256) { float gd = 1.0f;
            for (int c = 0; c < 16; ++c) gd *= DEC[(size_t)((16 * g + c) * 4 + h) * 256 + tid_];
            GD[(size_t)(g * 4 + h) * 256 + tid_] = gd; }
    }
    if (G2_SPLIT && F.G > 240 && F.vcu >= 240) gla_g2_phase(F, 1024, NCH * 4, F.vcu - 240, F.G - 240);
}
__device__ __forceinline__ void gla_carry_phase(Frame& F) {
    const int tid_ = fresh_tid();
    float* SL = (float*)(F_WS + WS_SL); const float* GD = (const float*)(F_WS + WS_GD);
    for (int e = blockIdx.x * (NWAVES * 64) + tid_; e < 4 * 256 * 128; e += F.G * NWAVES * 64) {
        const int v4 = e & 127, k = (e >> 7) & 255, h = e >> 15;
        f32x4 S = {0.f, 0.f, 0.f, 0.f};
        f32x4 t[15]; float gd[15];
#pragma unroll
        for (int g = 0; g < 15; ++g) { t[g] = *(const f32x4*)(SL + ((size_t)(g * 4 + h) * 256 + k) * 512 + 4 * v4); gd[g] = GD[(size_t)(g * 4 + h) * 256 + k]; }
#pragma unroll
        for (int g = 0; g < 15; ++g) { *(f32x4*)(SL + ((size_t)(g * 4 + h) * 256 + k) * 512 + 4 * v4) = S; S = S * gd[g] + t[g]; }
        *(f32x4*)(SL + ((size_t)(15 * 4 + h) * 256 + k) * 512 + 4 * v4) = S;
    }
}
__device__ __forceinline__ void gla_pass2_phase(Frame& F, bool with_sample = true) {
    const int tid_ = fresh_tid(), lane_ = tid_ & 63, wave_ = __builtin_amdgcn_readfirstlane(tid_ >> 6);
    const int fr = lane_ & 15, fq = lane_ >> 4;
    const float* SL = (const float*)(F_WS + WS_SL);
    for (int id = F.vcu; with_sample && id < 128; id += F.G) {
        const int b = id >> 4, h = (id >> 2) & 3, slice = id & 3; const int vc = slice * 128 + wave_ * 16 + fr;
        const float* s0 = F_IN(IN_STATE) + ((size_t)(b * 4 + h) * 256) * 512; float* s1 = F_OUT + O_SS + ((size_t)(b * 4 + h) * 256) * 512;
        const unsigned slo = (unsigned)(4 * fq) * 512 + (unsigned)vc;
        f32x4 S[16];
#pragma unroll
        for (int mi = 0; mi < 16; ++mi)
#pragma unroll
            for (int j = 0; j < 4; ++j) S[mi][j] = (s0 + (size_t)(16 * mi + j) * 512)[slo];
        gla_unit<true>(F, S, 256 + b, 1, h, slice, TP + 16 * b, 64, 16, tid_, wave_, fr, fq);
#pragma unroll
        for (int mi = 0; mi < 16; ++mi)
#pragma unroll
            for (int j = 0; j < 4; ++j) (s1 + (size_t)(16 * mi + j) * 512)[slo] = S[mi][j];
    }
    for (int id = F.vcu; id < 256; id += F.G) {
        const int g = id >> 4, h = (id >> 2) & 3, slice = id & 3; const int vc = slice * 128 + wave_ * 16 + fr;
        const float* s0 = SL + ((size_t)(g * 4 + h) * 256) * 512; const unsigned slo = (unsigned)(4 * fq) * 512 + (unsigned)vc;
        f32x4 S[16];
#pragma unroll
        for (int mi = 0; mi < 16; ++mi)
#pragma unroll
            for (int j = 0; j < 4; ++j) S[mi][j] = (s0 + (size_t)(16 * mi + j) * 512)[slo];
        gla_unit<true>(F, S, 16 * g, 16, h, slice, 16 * g * 64, 64, 64, tid_, wave_, fr, fq);
        if (g == 15) { float* s1 = F_OUT + O_SP + ((size_t)h * 256) * 512;
#pragma unroll
            for (int mi = 0; mi < 16; ++mi)
#pragma unroll
                for (int j = 0; j < 4; ++j) (s1 + (size_t)(16 * mi + j) * 512)[slo] = S[mi][j]; }
    }
}
__device__ __forceinline__ void gla_gn_phase(Frame& F, bf16* OG) {
    const int tid_ = fresh_tid(), lane_ = tid_ & 63, wave_ = __builtin_amdgcn_readfirstlane(tid_ >> 6);
    const int gw = F.vcu * NWAVES + wave_, NGW = F.G * NWAVES;
    const bf16* OB = (const bf16*)(F_WS + WS_OB); const bf16* Gg = (const bf16*)(F_WS + WS_GG);
    const f32x4 gn0 = *(const f32x4*)(F_IN(IN_GNORM) + 8 * lane_), gn1 = *(const f32x4*)(F_IN(IN_GNORM) + 8 * lane_ + 4);
    v4u ovn = {0u, 0u, 0u, 0u}, gvn = {0u, 0u, 0u, 0u};
    if (gw < MR * 4) { const size_t off = (size_t)(gw >> 2) * D + (gw & 3) * 512 + 8 * lane_; ovn = *(const v4u*)(OB + off); gvn = *(const v4u*)(Gg + off); }
    for (int t = gw; t < MR * 4; t += NGW) {
        const int row = t >> 2, h = t & 3; const size_t off = (size_t)row * D + h * 512 + 8 * lane_;
        const v4u ov = ovn, gv = gvn;
        if (t + NGW < MR * 4) { const int t2 = t + NGW; const size_t off2 = (size_t)(t2 >> 2) * D + (t2 & 3) * 512 + 8 * lane_; ovn = *(const v4u*)(OB + off2); gvn = *(const v4u*)(Gg + off2); }
        float o[8], g[8];
#pragma unroll
        for (int i = 0; i < 4; ++i) { const unsigned ow = i == 0 ? ov.x : i == 1 ? ov.y : i == 2 ? ov.z : ov.w, gw2 = i == 0 ? gv.x : i == 1 ? gv.y : i == 2 ? gv.z : gv.w;
            o[2 * i] = bf2f((unsigned short)(ow & 0xffff)); o[2 * i + 1] = bf2f((unsigned short)(ow >> 16)); g[2 * i] = bf2f((unsigned short)(gw2 & 0xffff)); g[2 * i + 1] = bf2f((unsigned short)(gw2 >> 16)); }
        float ss = 0.f;
#pragma unroll
        for (int i = 0; i < 8; ++i) ss += o[i] * o[i];
        const float rinv = 1.0f / sqrtf(wave_sum(ss) * (1.0f / 512.0f) + RMS_EPS);
        float r[8];
#pragma unroll
        for (int i = 0; i < 8; ++i) r[i] = o[i] * rinv * (i < 4 ? gn0[i & 3] : gn1[i & 3]) * silu(g[i]);
        *(v4u*)(OG + off) = (v4u){pk2(r[0], r[1]), pk2(r[2], r[3]), pk2(r[4], r[5]), pk2(r[6], r[7])};
    }
}
struct AttnState { f32x4 o[8]; float m, l; };
template <class TabP, class VLoad>
__device__ __forceinline__ void attn_block(AttnState& st, const bf16x8 (&qf)[4], const bf16x8 (&kf)[2][4], TabP tab, int qpos, int kpos0, int nvalid_tiles, int fq, const VLoad& vload) {
    f32x4 s0 = {0.f, 0.f, 0.f, 0.f}, s1 = {0.f, 0.f, 0.f, 0.f};
#pragma unroll
    for (int s = 0; s < 4; ++s) { s0 = MFMA16(kf[0][s], qf[s], s0); s1 = MFMA16(kf[1][s], qf[s], s1); }
    const float scale = 0.08838834764831845f * 1.4426950408889634f;
    float sv[8]; float mx = -1e30f;
#pragma unroll
    for (int j = 0; j < 4; ++j) {
        int d0 = qpos - (kpos0 + 4 * fq + j); d0 = d0 < -256 ? -256 : (d0 > 256 ? 256 : d0);
        int d1 = qpos - (kpos0 + 16 + 4 * fq + j); d1 = d1 < -256 ? -256 : (d1 > 256 ? 256 : d1);
        sv[j] = s0[j] * scale + tab[d0 + 256];
        sv[4 + j] = nvalid_tiles > 1 ? s1[j] * scale + tab[d1 + 256] : -1e30f;
        mx = fmaxf(mx, fmaxf(sv[j], sv[4 + j]));
    }
    mx = rows_max(mx);
    const float mnew = fmaxf(st.m, mx), alpha = __builtin_amdgcn_exp2f(st.m - mnew);
    float p[8]; float rs = 0.f;
#pragma unroll
    for (int j = 0; j < 8; ++j) { p[j] = __builtin_amdgcn_exp2f(sv[j] - mnew); rs += p[j]; }
    st.l = st.l * alpha + rs;
    const bool grow = __builtin_amdgcn_ballot_w64(mnew > st.m) != 0ull;
    st.m = mnew;
    v4u pw; pw.x = pk2(p[0], p[1]); pw.y = pk2(p[2], p[3]); pw.z = pk2(p[4], p[5]); pw.w = pk2(p[6], p[7]);
    const bf16x8 pf = __builtin_bit_cast(bf16x8, pw);
#pragma unroll
    for (int dt = 0; dt < 8; ++dt) {
        const v2u lo = vload(dt, 0), hi = vload(dt, 1);
        const v4u vw = {lo.x, lo.y, hi.x, hi.y};
        if (grow) st.o[dt] = st.o[dt] * alpha;
        st.o[dt] = MFMA16(__builtin_bit_cast(bf16x8, vw), pf, st.o[dt]);
    }
}
__device__ __forceinline__ bf16x8 cvt8(const float* p) {
    const f32x4 a = *(const f32x4*)p, b = *(const f32x4*)(p + 4);
    const v4u w = {pk2(a.x, a.y), pk2(a.z, a.w), pk2(b.x, b.y), pk2(b.z, b.w)};
    return __builtin_bit_cast(bf16x8, w);
}
#ifndef AT_VPRE
#define AT_VPRE 2
#endif
#ifndef AT_RESCALE_ALWAYS
#define AT_RESCALE_ALWAYS 0
#endif
#ifndef AT_MODE2
#define AT_MODE2 1
#endif
#ifndef AT_SKEW
#define AT_SKEW 0
#endif
#ifndef AT_AHEAD2
#define AT_AHEAD2 0
#endif
#ifndef AT_BALANCE
#define AT_BALANCE 1
#endif
#ifndef AT_STAGGER
#define AT_STAGGER 0
#endif
constexpr int AT_KROW = 272, AT_VROW = 136;
constexpr int AT_KT = 0, AT_VT = 2 * 64 * AT_KROW, AT_TAB = AT_VT + (AT_SKEW ? 3 : 2) * 128 * AT_VROW, AT_END = AT_TAB + 16 * 516 * 4;
static_assert(AT_END <= LDSCTL_OFF, "attention LDS");
constexpr int AT_OS = 0, AT_ML = 65536;
template <int MODE>
__device__ __forceinline__ void attn_block64(AttnState& st, const bf16x8 (&qf)[4], const LAS unsigned char* kt, const LAS unsigned char* vt, const LAS float* tab, int qpos, int kpos0, int fr, int fq) {
    f32x4 sc[4];
#pragma unroll
    for (int t = 0; t < 4; ++t) { sc[t] = (f32x4){0.f, 0.f, 0.f, 0.f};
#pragma unroll
        for (int s = 0; s < 4; ++s) sc[t] = MFMA16(*(const LAS bf16x8*)(kt + (16 * t + fr) * AT_KROW + s * 64 + fq * 16), qf[s], sc[t]); }
    const LAS unsigned char* vp = vt + fr * AT_VROW + fq * 8;
    v2u vf[AT_VPRE ? AT_VPRE : 1][4];
#if AT_VPRE
#pragma unroll
    for (int dt = 0; dt < AT_VPRE; ++dt)
#pragma unroll
        for (int q = 0; q < 4; ++q) vf[dt][q] = *(const LAS v2u*)(vp + dt * 16 * AT_VROW + q * 32);
#endif
    const float scale = 0.08838834764831845f * 1.4426950408889634f;
    float sv[16]; float mx = -1e30f;
    const float ub = tab[512];
    const LAS float* tabn = tab + (qpos - kpos0 - 4 * fq + 256 - 63);
#pragma unroll
    for (int t = 0; t < 4; ++t)
#pragma unroll
        for (int j = 0; j < 4; ++j) {
            float bias = ub;
            if (MODE == 0) { int d0 = qpos - (kpos0 + 16 * t + 4 * fq + j); d0 = d0 < -256 ? -256 : (d0 > 256 ? 256 : d0); bias = tab[d0 + 256]; }
            if (MODE == 2) bias = tabn[63 - 16 * t - j];
            sv[4 * t + j] = sc[t][j] * scale + bias; mx = fmaxf(mx, sv[4 * t + j]); }
    mx = rows_max(mx);
    const float mnew = fmaxf(st.m, mx), alpha = __builtin_amdgcn_exp2f(st.m - mnew);
    float p[16]; float rs = 0.f;
#pragma unroll
    for (int j = 0; j < 16; ++j) { p[j] = __builtin_amdgcn_exp2f(sv[j] - mnew); rs += p[j]; }
    st.l = st.l * alpha + rs;
    const bool grow = __builtin_amdgcn_ballot_w64(mnew > st.m) != 0ull;
    st.m = mnew;
    const v4u pw0 = {pk2(p[0], p[1]), pk2(p[2], p[3]), pk2(p[4], p[5]), pk2(p[6], p[7])}, pw1 = {pk2(p[8], p[9]), pk2(p[10], p[11]), pk2(p[12], p[13]), pk2(p[14], p[15])};
    const bf16x8 pf0 = __builtin_bit_cast(bf16x8, pw0), pf1 = __builtin_bit_cast(bf16x8, pw1);
#if AT_RESCALE_ALWAYS
    (void)grow;
#pragma unroll
    for (int dt = 0; dt < 8; ++dt) st.o[dt] = st.o[dt] * alpha;
#else
    if (grow) {
        asm volatile("" ::: "memory");
#pragma unroll
        for (int dt = 0; dt < 8; ++dt) st.o[dt] = st.o[dt] * alpha;
    }
#endif
#pragma unroll
    for (int dt = 0; dt < 8; ++dt) {
#if AT_VPRE
        constexpr int NV_ = AT_VPRE; const int sl_ = dt % NV_;
        const v4u v0 = {vf[sl_][0].x, vf[sl_][0].y, vf[sl_][1].x, vf[sl_][1].y}, v1 = {vf[sl_][2].x, vf[sl_][2].y, vf[sl_][3].x, vf[sl_][3].y};
        st.o[dt] = MFMA16(__builtin_bit_cast(bf16x8, v0), pf0, st.o[dt]);
        st.o[dt] = MFMA16(__builtin_bit_cast(bf16x8, v1), pf1, st.o[dt]);
        if (dt + NV_ < 8) {
#pragma unroll
            for (int q = 0; q < 4; ++q) vf[sl_][q] = *(const LAS v2u*)(vp + (dt + NV_) * 16 * AT_VROW + q * 32);
        }
#else
        const LAS unsigned char* vq = vp + dt * 16 * AT_VROW;
        const v2u a0 = *(const LAS v2u*)vq, a1 = *(const LAS v2u*)(vq + 32), b0 = *(const LAS v2u*)(vq + 64), b1 = *(const LAS v2u*)(vq + 96);
        const v4u v0 = {a0.x, a0.y, a1.x, a1.y}, v1 = {b0.x, b0.y, b1.x, b1.y};
        st.o[dt] = MFMA16(__builtin_bit_cast(bf16x8, v0), pf0, st.o[dt]);
        st.o[dt] = MFMA16(__builtin_bit_cast(bf16x8, v1), pf1, st.o[dt]);
#endif
    }
}
struct AttnP { bf16x8 pf0, pf1; float alpha; bool grow; };
template <bool UNIB>
__device__ __forceinline__ void attn_qks(AttnState& st, AttnP& P, const bf16x8 (&qf)[4], const LAS unsigned char* kt, const LAS float* tab, int qpos, int kpos0, int fr, int fq) {
    f32x4 sc[4];
#pragma unroll
    for (int t = 0; t < 4; ++t) { sc[t] = (f32x4){0.f, 0.f, 0.f, 0.f};
#pragma unroll
        for (int s = 0; s < 4; ++s) sc[t] = MFMA16(*(const LAS bf16x8*)(kt + (16 * t + fr) * AT_KROW + s * 64 + fq * 16), qf[s], sc[t]); }
    const float scale = 0.08838834764831845f * 1.4426950408889634f;
    float sv[16]; float mx = -1e30f;
    const float ub = tab[512];
#pragma unroll
    for (int t = 0; t < 4; ++t)
#pragma unroll
        for (int j = 0; j < 4; ++j) {
            float bias = ub;
            if (!UNIB) { int d0 = qpos - (kpos0 + 16 * t + 4 * fq + j); d0 = d0 < -256 ? -256 : (d0 > 256 ? 256 : d0); bias = tab[d0 + 256]; }
            sv[4 * t + j] = sc[t][j] * scale + bias; mx = fmaxf(mx, sv[4 * t + j]); }
    mx = rows_max(mx);
    const float mnew = fmaxf(st.m, mx), alpha = __builtin_amdgcn_exp2f(st.m - mnew);
    float p[16]; float rs = 0.f;
#pragma unroll
    for (int j = 0; j < 16; ++j) { p[j] = __builtin_amdgcn_exp2f(sv[j] - mnew); rs += p[j]; }
    st.l = st.l * alpha + rs;
    P.grow = __builtin_amdgcn_ballot_w64(mnew > st.m) != 0ull; P.alpha = alpha;
    st.m = mnew;
    const v4u pw0 = {pk2(p[0], p[1]), pk2(p[2], p[3]), pk2(p[4], p[5]), pk2(p[6], p[7])}, pw1 = {pk2(p[8], p[9]), pk2(p[10], p[11]), pk2(p[12], p[13]), pk2(p[14], p[15])};
    P.pf0 = __builtin_bit_cast(bf16x8, pw0); P.pf1 = __builtin_bit_cast(bf16x8, pw1);
}
__device__ __forceinline__ void attn_pv(AttnState& st, const AttnP& P, const LAS unsigned char* vt, int fr, int fq) {
    if (P.grow) {
        asm volatile("" ::: "memory");
#pragma unroll
        for (int dt = 0; dt < 8; ++dt) st.o[dt] = st.o[dt] * P.alpha;
    }
#pragma unroll
    for (int dt = 0; dt < 8; ++dt) {
        const LAS unsigned char* vp = vt + (dt * 16 + fr) * AT_VROW + fq * 8;
        const v2u a0 = *(const LAS v2u*)vp, a1 = *(const LAS v2u*)(vp + 32), b0 = *(const LAS v2u*)(vp + 64), b1 = *(const LAS v2u*)(vp + 96);
        const v4u v0 = {a0.x, a0.y, a1.x, a1.y}, v1 = {b0.x, b0.y, b1.x, b1.y};
        st.o[dt] = MFMA16(__builtin_bit_cast(bf16x8, v0), P.pf0, st.o[dt]);
        st.o[dt] = MFMA16(__builtin_bit_cast(bf16x8, v1), P.pf1, st.o[dt]);
    }
}
#ifndef AT_PINGPONG
#define AT_PINGPONG 0
#endif
template <bool COMPUTE = true, int ABL = 0>
__device__ __forceinline__ void attn_phase(Frame& F, const bf16* Qb, bf16* Ob) {
    const int tid_ = fresh_tid(), lane_ = tid_ & 63, wave_ = __builtin_amdgcn_readfirstlane(tid_ >> 6); (void)lane_; (void)wave_;
    const bf16* Kb = (const bf16*)(F_WS + WS_KB); const bf16* VTb = (const bf16*)(F_WS + WS_VTB); const bf16* VTC = (const bf16*)(F_WS + WS_VTC);
    const int fr = lane_ & 15, fq = lane_ >> 4;
    for (int sidx = F.vcu; COMPUTE && !(ABL & 4) && sidx < 128; sidx += F.G) {
        const int b = sidx >> 4, h = sidx & 15; const size_t qrow = (size_t)TP + b * 16 + fr;
        LAS float* tab = (LAS float*)(F.lds + AT_ML + 1024);
        for (int i = tid_; i < 513; i += NWAVES * 64) tab[i] = F_IN(IN_REL)[h * 513 + i] * 1.4426950408889634f;
        __syncthreads();
        AttnState st;
#pragma unroll
        for (int dt = 0; dt < 8; ++dt) st.o[dt] = (f32x4){0.f, 0.f, 0.f, 0.f};
        st.m = -1e30f; st.l = 0.f;
        bf16x8 qf[4];
#pragma unroll
        for (int s = 0; s < 4; ++s) {
            const float* qp = (const float*)(F_WS + WS_ZSP) + (size_t)(b * 16 + fr) * D + h * 128 + s * 32 + fq * 8;
            f32x4 q0 = *(const f32x4*)qp, q1 = *(const f32x4*)(qp + 4);
#pragma unroll
            for (int pc = 1; pc < 8; ++pc) { q0 += *(const f32x4*)(qp + (size_t)pc * 128 * D); q1 += *(const f32x4*)(qp + (size_t)pc * 128 * D + 4); }
            const v4u qw = {pk2(q0.x, q0.y), pk2(q0.z, q0.w), pk2(q1.x, q1.y), pk2(q1.z, q1.w)};
            qf[s] = __builtin_bit_cast(bf16x8, qw); }
        const float* ck = F_IN(IN_CK) + (size_t)b * 512 * D + h * 128;
        for (int blk = wave_; blk < 17; blk += NWAVES) {
            if (blk < 16) {
                const int kb = blk * 32;
                bf16x8 kf[2][4];
#pragma unroll
                for (int t = 0; t < 2; ++t)
#pragma unroll
                    for (int s = 0; s < 4; ++s) kf[t][s] = cvt8(ck + (size_t)(kb + 16 * t + fr) * D + s * 32 + fq * 8);
                const bf16* vb = VTC + ((size_t)b * 2048 + h * 128 + fr) * 512 + kb + 4 * fq;
                v2u vr[8][2];
#pragma unroll
                for (int dt = 0; dt < 8; ++dt) { vr[dt][0] = *(const v2u*)(vb + (size_t)dt * 16 * 512); vr[dt][1] = *(const v2u*)(vb + (size_t)dt * 16 * 512 + 16); }
                attn_block(st, qf, kf, tab, 512 + fr, kb, 2, fq, [&](int dt, int half) { return vr[dt][half]; });
            } else {
                bf16x8 kf[2][4];
#pragma unroll
                for (int s = 0; s < 4; ++s) { kf[0][s] = *(const bf16x8*)(Kb + ((size_t)TP + b * 16 + fr) * D + h * 128 + s * 32 + fq * 8); kf[1][s] = kf[0][s]; }
                const bf16* vb = VTb + (size_t)(h * 128 + fr) * MP + TP + b * 16 + 4 * fq;
                attn_block(st, qf, kf, tab, 512 + fr, 512, 1, fq, [&](int dt, int half) { return *(const v2u*)(vb + (size_t)dt * 16 * MP + half * 16); });
            }
        }
        float l = rows_sum(st.l);
        LAS f32x4* OS = (LAS f32x4*)(F.lds + AT_OS); LAS f32x2v* ML = (LAS f32x2v*)(F.lds + AT_ML);
#pragma unroll
        for (int dt = 0; dt < 8; ++dt) OS[(wave_ * 8 + dt) * 64 + lane_] = st.o[dt];
        if (fq == 0) ML[wave_ * 16 + fr] = (f32x2v){st.m, l};
        __syncthreads();
        {
            float M = -1e30f; f32x2v ml[8];
#pragma unroll
            for (int w = 0; w < 8; ++w) { ml[w] = ML[w * 16 + fr]; M = fmaxf(M, ml[w].x); }
            float L = 0.f; f32x4 o = {0.f, 0.f, 0.f, 0.f};
#pragma unroll
            for (int w = 0; w < 8; ++w) { const float e = __builtin_amdgcn_exp2f(ml[w].x - M); L += ml[w].y * e; o += OS[(w * 8 + wave_) * 64 + lane_] * e; }
            o = o * (1.0f / L);
            *(v2u*)(Ob + qrow * D + h * 128 + wave_ * 16 + 4 * fq) = (v2u){pk2(o[0], o[1]), pk2(o[2], o[3])};
        }
        __syncthreads();
    }
    LAS unsigned char* Kt = F.lds + AT_KT; LAS unsigned char* Vt = F.lds + AT_VT; LAS float* TbAll = (LAS float*)(F.lds + AT_TAB);
    const int k_key = tid_ >> 4, k_seg = tid_ & 15, v_d = tid_ >> 2, v_seg = tid_ & 3;
    __syncthreads();
    for (int i = tid_; i < 16 * 513; i += NWAVES * 64) { const int hh = i / 513, e = i - hh * 513; TbAll[hh * 516 + e] = F_IN(IN_REL)[i] * 1.4426950408889634f; }
#define AT_LOAD(R, KG, VG, blk) do { R[0] = *(const v4u*)((KG) + (size_t)(blk) * 64 * D); R[1] = *(const v4u*)((KG) + (size_t)((blk) * 64 + 32) * D); R[2] = *(const v4u*)((VG) + (blk) * 64); R[3] = *(const v4u*)((VG) + (blk) * 64 + 32); } while (0)
#define AT_STORE2(R, kbuf, vbuf) do { LAS unsigned char* kd_ = Kt + (kbuf) * (64 * AT_KROW) + k_key * AT_KROW + k_seg * 16; *(LAS v4u*)kd_ = R[0]; *(LAS v4u*)(kd_ + 32 * AT_KROW) = R[1]; \
            LAS unsigned char* vd_ = Vt + (vbuf) * (128 * AT_VROW) + v_d * AT_VROW + v_seg * 16; *(LAS v2u*)vd_ = (v2u){R[2].x, R[2].y}; *(LAS v2u*)(vd_ + 8) = (v2u){R[2].z, R[2].w}; \
            *(LAS v2u*)(vd_ + 64) = (v2u){R[3].x, R[3].y}; *(LAS v2u*)(vd_ + 72) = (v2u){R[3].z, R[3].w}; } while (0)
#define AT_STORE(R, buf) AT_STORE2(R, buf, buf)
#define AT_TASK(ID, H_, QT_, QROW_, KBLO_, NBLK_, WLO_, WHI_, KG_, VG_) do { H_ = (ID) >> 7; const int cp_ = (ID) & 127, n0_ = 2 * cp_, n_ = n0_ + (wave_ >> 2); QT_ = 8 * cp_ + wave_; QROW_ = (size_t)QT_ * 16 + fr; \
            KBLO_ = (n0_ > 8 ? n0_ - 8 : 0) * 64; NBLK_ = ((n0_ + 2) * 64 - KBLO_) >> 6; WLO_ = (n_ > 8 ? n_ - 8 : 0) * 64; WHI_ = (n_ + 1) * 64; \
            KG_ = Kb + (size_t)(KBLO_ + k_key) * D + H_ * 128 + k_seg * 8; VG_ = VTb + (size_t)(H_ * 128 + v_d) * MP + KBLO_ + v_seg * 8; } while (0)
    const bool bal_ = AT_BALANCE && F.G == 256;
#define AT_TASKID(k) (bal_ ? ((k) < 7 ? F.vcu + 256 * (k) : (F.vcu >= 128 && (k) < 9 ? 1792 + 128 * ((k) - 7) + (F.vcu - 128) : 2048)) : F.vcu + F.G * (k))
    int id = F.vcu, kq_ = 0;
    if (id < 2048 && !(ABL & 8)) {
        int h, qt, kb_lo, nblk, wlo, whi; size_t qrow; const bf16* kg; const bf16* vg;
        AT_TASK(id, h, qt, qrow, kb_lo, nblk, wlo, whi, kg, vg);
        v4u r0[4]; bf16x8 qf[4];
#if AT_AHEAD2
        v4u r1[4];
        AT_LOAD(r0, kg, vg, 0); AT_LOAD(r1, kg, vg, 1);
#else
        AT_LOAD(r0, kg, vg, 0);
#endif
#pragma unroll
        for (int s = 0; s < 4; ++s) qf[s] = *(const bf16x8*)(Qb + qrow * D + h * 128 + s * 32 + fq * 8);
        AT_STORE(r0, 0);
        __syncthreads();
        int vs_ = 0, vprev_ = 0; (void)vs_; (void)vprev_;
        for (;;) {
            const int nid = AT_TASKID(kq_ + 1); const bool has_next = nid < 2048;
            int hN = 0, qtN = 0, kb_loN = 0, nblkN = 0, wloN = 0, whiN = 0; size_t qrowN = 0; const bf16* kgN = kg; const bf16* vgN = vg;
            if (has_next) AT_TASK(nid, hN, qtN, qrowN, kb_loN, nblkN, wloN, whiN, kgN, vgN);
            bf16x8 qn[4];
#pragma unroll
            for (int s = 0; s < 4; ++s) qn[s] = qf[s];
            const LAS float* Tb = TbAll + h * 516;
            AttnState st;
#pragma unroll
            for (int dt = 0; dt < 8; ++dt) st.o[dt] = (f32x4){0.f, 0.f, 0.f, 0.f};
            st.m = -1e30f; st.l = 0.f;
#if AT_SKEW
#define AT_QKS(kb_, kt_) do { if ((kb_) + 63 + 256 <= 16 * qt) attn_qks<true>(st, PP, qf, kt_, Tb, (int)qrow, kb_, fr, fq); else attn_qks<false>(st, PP, qf, kt_, Tb, (int)qrow, kb_, fr, fq); } while (0)
#define AT_STEP(bi, RL, RW) do { const int kb_ = kb_lo + 64 * (bi), cur_ = (bi) & 1; \
            if (!(ABL & 1)) { if ((bi) + 1 < nblk) AT_LOAD(r0, kg, vg, (bi) + 1); else if (has_next) AT_LOAD(r0, kgN, vgN, 0); } \
            if ((bi) + 1 == nblk && has_next) { _Pragma("unroll") for (int s = 0; s < 4; ++s) qn[s] = *(const bf16x8*)(Qb + qrowN * D + hN * 128 + s * 32 + fq * 8); } \
            const LAS unsigned char* kt = Kt + cur_ * (64 * AT_KROW); const LAS unsigned char* vt = Vt + vs_ * (128 * AT_VROW); \
            const bool act_ = kb_ >= wlo && kb_ < whi; \
            if (lo_) { if (act_) { \
                if (kb_ + 63 + 256 <= 16 * qt) attn_block64<1>(st, qf, kt, vt, Tb, (int)qrow, kb_, fr, fq); \
                else if (AT_MODE2 && 16 * qt + 15 - kb_ <= 256) attn_block64<2>(st, qf, kt, vt, Tb, (int)qrow, kb_, fr, fq); \
                else attn_block64<0>(st, qf, kt, vt, Tb, (int)qrow, kb_, fr, fq); } } \
            else { if (pend_) attn_pv(st, PP, Vt + vprev_ * (128 * AT_VROW), fr, fq); pend_ = false; if (act_) { AT_QKS(kb_, kt); pend_ = true; } } \
            const int vn_ = vs_ == 2 ? 0 : vs_ + 1; \
            if (!(ABL & 1)) { if ((bi) + 1 < nblk || has_next) AT_STORE2(r0, cur_ ^ 1, vn_); } \
            vprev_ = vs_; vs_ = vn_; \
            __syncthreads(); } while (0)
            AttnP PP; bool pend_ = false; const bool lo_ = wave_ < 4;
            for (int bi = 0; bi < nblk; bi += 2) { AT_STEP(bi, r0, r0); AT_STEP(bi + 1, r0, r0); }
            if (pend_) attn_pv(st, PP, Vt + vprev_ * (128 * AT_VROW), fr, fq);
#undef AT_QKS
#elif AT_PINGPONG
#define AT_QKS(kb_, kt_) do { if ((kb_) + 63 + 256 <= 16 * qt) attn_qks<true>(st, PP, qf, kt_, Tb, (int)qrow, kb_, fr, fq); else attn_qks<false>(st, PP, qf, kt_, Tb, (int)qrow, kb_, fr, fq); } while (0)
#define AT_STEP(bi, RL, RW) do { const int kb_ = kb_lo + 64 * (bi), cur_ = (bi) & 1; \
            if ((bi) + 2 < nblk) AT_LOAD(RL, kg, vg, (bi) + 2); else if (has_next) AT_LOAD(RL, kgN, vgN, (bi) + 2 - nblk); \
            if ((bi) + 1 == nblk && has_next) { _Pragma("unroll") for (int s = 0; s < 4; ++s) qn[s] = *(const bf16x8*)(Qb + qrowN * D + hN * 128 + s * 32 + fq * 8); } \
            const LAS unsigned char* kt = Kt + cur_ * (64 * AT_KROW); const LAS unsigned char* vt = Vt + cur_ * (128 * AT_VROW); const LAS unsigned char* vtp = Vt + (cur_ ^ 1) * (128 * AT_VROW); \
            const bool act_ = kb_ >= wlo && kb_ < whi; \
            if (lo_) { if (act_) AT_QKS(kb_, kt); } else { if (pend_) attn_pv(st, PP, vtp, fr, fq); pend_ = false; } \
            __syncthreads(); \
            if (lo_) { if (act_) attn_pv(st, PP, vt, fr, fq); } else { if (act_) { AT_QKS(kb_, kt); pend_ = true; } } \
            if ((bi) + 1 < nblk || has_next) AT_STORE(RW, cur_ ^ 1); \
            __syncthreads(); } while (0)
            AttnP PP; bool pend_ = false; const bool lo_ = wave_ < 4;
            for (int bi = 0; bi < nblk; bi += 2) { AT_STEP(bi, r0, r1); AT_STEP(bi + 1, r1, r0); }
            if (pend_) attn_pv(st, PP, Vt + 1 * (128 * AT_VROW), fr, fq);
#undef AT_QKS
#elif AT_AHEAD2
#define AT_STEP(bi, RL, RW) do { const int kb_ = kb_lo + 64 * (bi), cur_ = (bi) & 1; \
            if ((bi) + 2 < nblk) AT_LOAD(RL, kg, vg, (bi) + 2); else if (has_next) AT_LOAD(RL, kgN, vgN, (bi) + 2 - nblk); \
            if ((bi) + 1 == nblk && has_next) { _Pragma("unroll") for (int s = 0; s < 4; ++s) qn[s] = *(const bf16x8*)(Qb + qrowN * D + hN * 128 + s * 32 + fq * 8); } \
            if (COMPUTE && kb_ >= wlo && kb_ < whi) { \
                const LAS unsigned char* kt = Kt + cur_ * (64 * AT_KROW); const LAS unsigned char* vt = Vt + cur_ * (128 * AT_VROW); \
                if (kb_ + 63 + 256 <= 16 * qt) attn_block64<1>(st, qf, kt, vt, Tb, (int)qrow, kb_, fr, fq); \
                else if (AT_MODE2 && 16 * qt + 15 - kb_ <= 256) attn_block64<2>(st, qf, kt, vt, Tb, (int)qrow, kb_, fr, fq); \
                else attn_block64<0>(st, qf, kt, vt, Tb, (int)qrow, kb_, fr, fq); } \
            if ((bi) + 1 < nblk || has_next) AT_STORE(RW, cur_ ^ 1); \
            __syncthreads(); } while (0)
            for (int bi = 0; bi < nblk; bi += 2) { AT_STEP(bi, r0, r1); AT_STEP(bi + 1, r1, r0); }
#else
#define AT_STEP(bi, RL, RW) do { const int kb_ = kb_lo + 64 * (bi), cur_ = (bi) & 1; \
            if (!(ABL & 1)) { if ((bi) + 1 < nblk) AT_LOAD(r0, kg, vg, (bi) + 1); else if (has_next) AT_LOAD(r0, kgN, vgN, 0); } \
            if ((bi) + 1 == nblk && has_next) { _Pragma("unroll") for (int s = 0; s < 4; ++s) qn[s] = *(const bf16x8*)(Qb + qrowN * D + hN * 128 + s * 32 + fq * 8); } \
            if (COMPUTE && kb_ >= wlo && kb_ < whi) { \
                const LAS unsigned char* kt = Kt + cur_ * (64 * AT_KROW); const LAS unsigned char* vt = Vt + cur_ * (128 * AT_VROW); \
                if (kb_ + 63 + 256 <= 16 * qt) attn_block64<1>(st, qf, kt, vt, Tb, (int)qrow, kb_, fr, fq); \
                else if (AT_MODE2 && 16 * qt + 15 - kb_ <= 256) attn_block64<2>(st, qf, kt, vt, Tb, (int)qrow, kb_, fr, fq); \
                else attn_block64<0>(st, qf, kt, vt, Tb, (int)qrow, kb_, fr, fq); } \
            if (!(ABL & 1)) { if ((bi) + 1 < nblk || has_next) AT_STORE(r0, cur_ ^ 1); } \
            __syncthreads(); } while (0)
            for (int bi = 0; bi < nblk; bi += 2) { AT_STEP(bi, r0, r0); AT_STEP(bi + 1, r0, r0); }
#endif
#undef AT_STEP
            if (COMPUTE && (ABL & 2)) { float l = rows_sum(st.l); float acc_ = l;
#pragma unroll
                for (int dt = 0; dt < 8; ++dt) acc_ += st.o[dt][0] + st.o[dt][1] + st.o[dt][2] + st.o[dt][3];
                if (acc_ == 1.2345e-30f) Ob[0] = 0; }
            if (COMPUTE && !(ABL & 2)) {
                float l = rows_sum(st.l);
                const float inv = 1.0f / l;
#pragma unroll
                for (int dt = 0; dt < 8; ++dt) { const f32x4 o = st.o[dt] * inv;
                    *(v2u*)(Ob + qrow * D + h * 128 + dt * 16 + 4 * fq) = (v2u){pk2(o[0], o[1]), pk2(o[2], o[3])}; }
            }
            if (!has_next) break;
            id = nid; ++kq_; h = hN; qt = qtN; qrow = qrowN; kb_lo = kb_loN; nblk = nblkN; wlo = wloN; whi = whiN; kg = kgN; vg = vgN;
#pragma unroll
            for (int s = 0; s < 4; ++s) qf[s] = qn[s];
        }
    }
#undef AT_LOAD
#undef AT_STORE
#undef AT_STORE2
#undef AT_TASK
#undef AT_TASKID
}
#ifndef PHDUP
#define PHDUP 0
#endif
#ifndef PHSEL
#define PHSEL 0x7fffffff
#endif
#ifndef G2_SPLIT
#define G2_SPLIT 1
#endif
#ifndef PHDUP_N
#define PHDUP_N 1
#endif
#ifndef PHDUP_NOEPI
#define PHDUP_NOEPI 0
#endif
#define PHASE(bit, ...) do { if constexpr ((PHSEL >> (bit)) & 1) { __VA_ARGS__; } if constexpr ((PHDUP >> (bit)) & 1) { for (int d_ = 0; d_ < PHDUP_N; ++d_) { __syncthreads(); dup_skip_ = PHDUP_NOEPI != 0; __VA_ARGS__; dup_skip_ = false; } } } while (0)
#define GEMM2(ORD, ...) do { typedef __VA_ARGS__ Ops_; ORD S_; S_.G = F.G; S_.c = (int)blockIdx.x; Ops_ E_{F.a, F.G}; pg8::gemm_phase2<Ops_, ORD>(F.lds, S_, E_, dup_skip_); } while (0)
typedef pg8::SegOrder<65, 43, 0, 0, 0, 0, 0, 0, 32> OrdUp;
typedef pg8::SegOrder<64, 8, 0, 0, 0, 0, 21, 8, 86> OrdDown;
typedef pg8::SegOrder<64, 8, 0, 0, 0, 0, 8, 8, 32> OrdOut;
typedef pg8::SegOrder<65, 17, 8, 65, 0, 0, 0, 0, 32> OrdAin;
typedef pg8::SegOrder<65, 8, 8, 65, 65, 43, 0, 0, 32> OrdKVUp;
typedef pg8::SegOrder<64, 8, 0, 0, 0, 0, 8, 8, 32> OrdQ;

__global__ void __launch_bounds__(NWAVES * 64, 2) trunk_fwd(Args args) {
    extern __shared__ __attribute__((aligned(16))) unsigned char lds[];
    Frame F; bool dup_skip_ = false; (void)dup_skip_;
    F.lds = (LAS unsigned char*)lds;
    F.G = gridDim.x; { const int bx = blockIdx.x; F.vcu = (F.G % 8 == 0) ? (bx % 8) * (F.G / 8) + bx / 8 : bx; }
    F.a = (ArgsP)__builtin_amdgcn_kernarg_segment_ptr(); (void)args;
#define WSP (F.a->ws)
    volatile LAS unsigned* MISC = (volatile LAS unsigned*)(F.lds + MISC_OFF);
    for (int u = threadIdx.x; u < (LDS_BYTES - LDSCTL_OFF) / 4; u += NWAVES * 64) ((LAS unsigned*)(F.lds + LDSCTL_OFF))[u] = 0u;
    __syncthreads();
    XcdBarrier bar = xcd_barrier_post((unsigned*)(WSP + WS_CTL) + CW_BAR, MISC + 8);
#ifdef PROBE_BAR2
#define GRID_BAR() do { xcd_barrier(bar); xcd_barrier(bar); } while (0)
#else
#define GRID_BAR() xcd_barrier(bar)
#endif
#define H ((bf16*)(WSP + WS_H))
#define H2 ((bf16*)(WSP + WS_H2))
#define XA ((float*)(WSP + WS_XA))
#define Z ((float*)(WSP + WS_Z))
#define lng (F_IN(IN_LNG))
#define lnb (F_IN(IN_LNB))

    PHASE(1, p0_ada(F));
    __syncthreads();
    PHASE(0, p0_convert(F));
    GRID_BAR();
    PHASE(2, mod0_phase(F));
    GRID_BAR();
    PHASE(3, GEMM2(OrdUp, pg8::OpsUp<WS_WUP + 0 * SZ_WUP, 0, 0, 0>));
    GRID_BAR();
    PHASE(4, GEMM2(OrdDown, pg8::OpsRes<WS_HID, WS_WDN + 0 * SZ_WDN, FF, 0, ada_off(0, 0, 2), 1>));
    GRID_BAR();
    PHASE(5, ln_phase<0>(F, ada_off(0, 1, 0), ada_off(0, 1, 1), H, -1, -1, nullptr, ada_off(0, 0, 2), 0.5f, 21));
    GRID_BAR();
    PHASE(6, GEMM2(OrdAin, pg8::OpsAin));
    GRID_BAR();
    PHASE(8, gla_g2_phase(F, 0, G2_SPLIT && F.G > 240 ? 1024 : NCH * 4, F.vcu, F.G));
    GRID_BAR();
    PHASE(9, gla_pass1_phase(F));
    GRID_BAR();
    PHASE(15, gla_carry_phase(F));
    GRID_BAR();
    PHASE(11, gla_pass2_phase(F, !dup_skip_));
    GRID_BAR();
    PHASE(10, gla_gn_phase(F, H));
    GRID_BAR();
    PHASE(7, GEMM2(OrdOut, pg8::OpsRes<WS_H, WS_WAO, D, 1, ada_off(0, 1, 2), 0>));
    GRID_BAR();
    PHASE(5, ln_phase<1>(F, ada_off(0, 2, 0), ada_off(0, 2, 1), H, -1, -1, nullptr, ada_off(0, 1, 2), 1.0f, 8));
    GRID_BAR();
    PHASE(3, GEMM2(OrdUp, pg8::OpsUp<WS_WUP + 1 * SZ_WUP, 0, 0, 0>));
    GRID_BAR();
    PHASE(4, GEMM2(OrdDown, pg8::OpsRes<WS_HID, WS_WDN + 1 * SZ_WDN, FF, 2, ada_off(0, 2, 2), 1>));
    GRID_BAR();
    PHASE(5, ln_phase<2>(F, ada_off(1, 0, 0), ada_off(1, 0, 1), H, ADA_KV_SHIFT, ADA_KV_SCALE, H2, ada_off(0, 2, 2), 0.5f, 21));
    GRID_BAR();
    PHASE(12, GEMM2(OrdKVUp, pg8::OpsKVUp<WS_WUP + 2 * SZ_WUP, 0, 0, 0>));
    GRID_BAR();
    PHASE(4, GEMM2(OrdDown, pg8::OpsRes<WS_HID, WS_WDN + 2 * SZ_WDN, FF, 3, ada_off(1, 0, 2), 1>));
    GRID_BAR();
    PHASE(5, ln_phase<3>(F, ada_off(1, 1, 0), ada_off(1, 1, 1), H, -1, -1, nullptr, ada_off(1, 0, 2), 0.5f, 21));
    GRID_BAR();
    PHASE(13, GEMM2(OrdQ, pg8::OpsQ));
    GRID_BAR();
#ifndef ATT_REP
#define ATT_REP 1
#endif
    #ifdef ATT_SKEL
#ifndef ATT_SKEL_ABL
#define ATT_SKEL_ABL 0
#define ATT_SKEL_COMPUTE false
#endif
    attn_phase<true>(F, H2, H);
    for (int rep_ = 1; rep_ < ATT_REP; ++rep_) { __syncthreads(); attn_phase<ATT_SKEL_COMPUTE, ATT_SKEL_ABL>(F, H2, H); }
#else
    for (int rep_ = 0; rep_ < ATT_REP; ++rep_) { if (rep_) __syncthreads(); attn_phase<true>(F, H2, H); }
#endif
    GRID_BAR();
    PHASE(7, GEMM2(OrdOut, pg8::OpsRes<WS_H, WS_WBO, D, 4, ada_off(1, 1, 2), 0>));
    GRID_BAR();
    PHASE(5, ln_phase<4>(F, ada_off(1, 2, 0), ada_off(1, 2, 1), H, -1, -1, nullptr, ada_off(1, 1, 2), 1.0f, 8));
    GRID_BAR();
    PHASE(3, GEMM2(OrdUp, pg8::OpsUp<WS_WUP + 3 * SZ_WUP, 0, 0, 0>));
    GRID_BAR();
    PHASE(4, GEMM2(OrdDown, pg8::OpsRes<WS_HID, WS_WDN + 3 * SZ_WDN, FF, 5, ada_off(1, 2, 2), 1>));
    GRID_BAR();
    PHASE(5, ln_phase<5>(F, -1, -1, nullptr, -1, -1, nullptr, ada_off(1, 2, 2), 0.5f, 21));
#undef WSP
#undef H
#undef H2
#undef XA
#undef Z
#undef lng
#undef lnb
}

extern "C" void kernel_launch(void* const* d_in, const int* in_sizes, int n_in, void* d_out, int out_size, void* d_ws, size_t ws_size, hipStream_t stream) {
    static int grid = 0;
    if (grid == 0) {
        if (n_in != 24 || ws_size < WS_END) { fprintf(stderr, "kernel_launch: unexpected problem (n_in %d, ws %zu, need %zu)\n", n_in, ws_size, (size_t)WS_END); grid = -1; return; }
        int dev = 0, cus = 0, per_cu = 0;
        if (hipGetDevice(&dev) != hipSuccess || hipDeviceGetAttribute(&cus, hipDeviceAttributeMultiprocessorCount, dev) != hipSuccess) { grid = -1; return; }
        if (hipFuncSetAttribute((const void*)trunk_fwd, hipFuncAttributeMaxDynamicSharedMemorySize, LDS_BYTES) != hipSuccess) { fprintf(stderr, "kernel_launch: hipFuncSetAttribute failed\n"); grid = -1; return; }
        if (hipOccupancyMaxActiveBlocksPerMultiprocessor(&per_cu, (const void*)trunk_fwd, NWAVES * 64, LDS_BYTES) != hipSuccess || per_cu < 1) { fprintf(stderr, "kernel_launch: occupancy query says %d blocks per CU\n", per_cu); }
        (void)hipGetLastError();
        grid = cus;
    }
    if (grid < 0) return;
    (void)in_sizes; (void)out_size;
    if (hipMemsetAsync((char*)d_ws + WS_CTL, 0, CTL_ZERO_BYTES, stream) != hipSuccess) return;
    Args a{};
    for (int i = 0; i < 24; ++i) a.in[i] = (const float*)d_in[i];
    a.out = (float*)d_out; a.ws = (unsigned char*)d_ws;
    hipLaunchKernelGGL(trunk_fwd, dim3(grid), dim3(NWAVES * 64), LDS_BYTES, stream, a);
}
```

```cpp
#include <hip/hip_runtime.h>
#include <cstdio>
#include <cstdint>
#ifndef PG8_ALIGN_EPI
#define PG8_ALIGN_EPI true
#endif
#ifndef PG8_WGM
#define PG8_WGM 4
#endif
#ifndef W_TILED
#define W_TILED 1
#endif
#ifndef VT_BLOCKED
#define VT_BLOCKED 0
#endif
#ifndef PG8_PIECES_FIRST
#define PG8_PIECES_FIRST 0
#endif
#ifndef PG8_SP2
#define PG8_SP2 true
#endif
constexpr int NWAVES = 8;
constexpr int D = 2048, TP = 16384, NSR = 128, MR = 16512, MP = 16640, FF = 5504, FF2 = 11008;
constexpr int NCH = 264;
constexpr int ADA_LD = 40960;
constexpr float LN_EPS = 1e-5f, RMS_EPS = 1e-6f;
constexpr size_t O_YP = 0, O_YS = 33554432, O_SP = 33816576, O_SS = 34340864, O_KP = 38535168, O_VP = 39583744, O_KS = 40632320, O_VS = 40894464;
constexpr size_t MiB = 1u << 20;
constexpr size_t WS_CTL = 0, CTL_ZERO_BYTES = 1 * MiB;
constexpr size_t WS_ADA = 1 * MiB;
constexpr size_t SZ_WUP = (size_t)FF2 * D * 2, SZ_WDN = (size_t)D * FF * 2, SZ_SQ = (size_t)D * D * 2;
constexpr size_t WS_WUP = 3 * MiB;
constexpr size_t WS_WDN = WS_WUP + 4 * SZ_WUP;
constexpr size_t WS_WAN = WS_WDN + 4 * SZ_WDN;
constexpr size_t WS_WAV = WS_WAN + (size_t)4352 * D * 2;
constexpr size_t WS_WAO = WS_WAV + SZ_SQ;
constexpr size_t WS_WK = WS_WAO + SZ_SQ, WS_WV = WS_WK + SZ_SQ, WS_WQ = WS_WV + SZ_SQ, WS_WBO = WS_WQ + SZ_SQ;
constexpr size_t WS_VTC = WS_WBO + SZ_SQ;
constexpr size_t SZ_F32ACT = (size_t)MP * D * 4, SZ_B16ACT = (size_t)MP * D * 2;
constexpr size_t WS_ZSP = WS_VTC + (size_t)8 * 2048 * 512 * 2;
constexpr size_t WS_XS = WS_ZSP + (size_t)21 * 128 * D * 4;
constexpr size_t WS_STAT = WS_XS + (size_t)128 * D * 4;
constexpr size_t WS_XA = WS_STAT + (size_t)TP * 2 * 4;
constexpr size_t WS_ZB0 = WS_XA, WS_ZB1 = WS_XA + SZ_B16ACT;
constexpr size_t WS_Z = WS_XA + SZ_F32ACT;
constexpr size_t WS_H = WS_Z + SZ_F32ACT;
constexpr size_t WS_H2 = WS_H + SZ_B16ACT;
constexpr size_t WS_R1 = WS_H2 + SZ_B16ACT;
constexpr size_t WS_HID = WS_R1;
constexpr size_t SZ_HID = (size_t)MP * FF * 2;
constexpr size_t WS_QG = WS_R1, WS_KG = WS_QG + (size_t)MP * 1024 * 2, WS_GG = WS_KG + (size_t)MP * 1024 * 2, WS_VTG = WS_GG + SZ_B16ACT;
constexpr size_t WS_GKL = WS_VTG + SZ_B16ACT;
constexpr size_t WS_QT = WS_GKL + (size_t)MP * 16 * 4;
constexpr size_t SZ_QT = (size_t)NCH * 4 * 64 * 256 * 2;
constexpr size_t WS_KDT = WS_QT + SZ_QT;
constexpr size_t WS_P = WS_KDT + SZ_QT;
constexpr size_t WS_DEC = WS_P + (size_t)NCH * 4 * 64 * 64 * 2;
constexpr size_t WS_UT = WS_DEC + (size_t)NCH * 4 * 256 * 4;
constexpr size_t WS_GLA_END = WS_UT + (size_t)NCH * 4 * 512 * 256 * 2;
constexpr size_t WS_KB = WS_R1 + ((SZ_HID + 255) / 256) * 256;
constexpr size_t WS_VTB = WS_KB + SZ_B16ACT;
constexpr size_t WS_ATT_END = WS_VTB + SZ_B16ACT;
constexpr size_t WS_END = WS_GLA_END > WS_ATT_END ? WS_GLA_END : WS_ATT_END;
static_assert(WS_END <= (size_t)1442840576, "d_ws map exceeds the guaranteed workspace (4 x largest input)");
static_assert(WS_WUP % 256 == 0 && WS_WDN % 256 == 0 && WS_XA % 256 == 0 && WS_R1 % 256 == 0 && WS_KB % 256 == 0 && WS_QT % 256 == 0 && WS_UT % 256 == 0 && WS_P % 256 == 0 && WS_DEC % 256 == 0, "alignment");
constexpr int CW_BAR = 4096, CW_WORK = 2048;
constexpr int RING_BYTES = 131072, LDS_BYTES = 147456, LDSCTL_OFF = LDS_BYTES - 512, MISC_OFF = LDSCTL_OFF + 320;

struct Args { const float* in[24]; float* out; unsigned char* ws; };
typedef const __attribute__((address_space(4))) Args* ArgsP;
__device__ __forceinline__ int fresh_tid() { int t; asm volatile("v_mov_b32 %0, %1" : "=v"(t) : "v"(threadIdx.x)); return t; }
#ifndef WT_STORES
#define WT_STORES 0
#endif
template <class V> __device__ __forceinline__ void st16_wt(void* p, const V& v) {
    static_assert(sizeof(V) == 16, "st16_wt stores 16 bytes");
#if WT_STORES
    asm volatile("global_store_dwordx4 %0, %1, off sc1\n\ts_nop 2" :: "v"(p), "v"(v) : "memory");
#else
    *(V*)p = v;
#endif
}
#define GAS __attribute__((address_space(1)))
#define LAS __attribute__((address_space(3)))
typedef unsigned short bf16;
typedef unsigned v4u __attribute__((ext_vector_type(4)));
typedef unsigned v2u __attribute__((ext_vector_type(2)));
typedef float f32x4 __attribute__((ext_vector_type(4)));
typedef float f32x2v __attribute__((ext_vector_type(2)));
typedef short bf16x8 __attribute__((ext_vector_type(8)));
typedef short s16x4 __attribute__((ext_vector_type(4)));
#define LDS_WAIT() asm volatile("s_waitcnt lgkmcnt(0)" ::: "memory")
#define VM_WAIT() asm volatile("s_waitcnt vmcnt(0)" ::: "memory")
__device__ __forceinline__ unsigned f2bf(float f) { unsigned u = __builtin_bit_cast(unsigned, f); return (u + 0x7fffu + ((u >> 16) & 1u)) >> 16; }
typedef __bf16 bf16x2_t __attribute__((ext_vector_type(2)));
__device__ __forceinline__ unsigned pk2(float lo, float hi) { const f32x2v v = {lo, hi}; const bf16x2_t b = __builtin_convertvector(v, bf16x2_t); return __builtin_bit_cast(unsigned, b); }
__device__ __forceinline__ float bf2f(unsigned short b) { return __builtin_bit_cast(float, ((unsigned)b) << 16); }
__device__ __forceinline__ float wave_sum(float v) {
#pragma unroll
    for (int o = 1; o < 64; o <<= 1) v += __shfl_xor(v, o);
    return v;
}
__device__ __forceinline__ void swap16(float& a, float& b) { asm("s_nop 1\n\tv_permlane16_swap_b32 %0, %1" : "+v"(a), "+v"(b)); }
__device__ __forceinline__ void swap32(float& a, float& b) { asm("s_nop 1\n\tv_permlane32_swap_b32 %0, %1" : "+v"(a), "+v"(b)); }
__device__ __forceinline__ float rows_max(float x) { float a = x, b = x; swap16(a, b); float t = fmaxf(a, b); a = t; b = t; swap32(a, b); return fmaxf(a, b); }
__device__ __forceinline__ float rows_sum(float x) { float a = x, b = x; swap16(a, b); float t = a + b; a = t; b = t; swap32(a, b); return a + b; }
__device__ __forceinline__ float silu(float a) { return a / (1.0f + __expf(-a)); }
#define MFMA16(a, b, c) __builtin_amdgcn_mfma_f32_16x16x32_bf16((a), (b), (c), 0, 0, 0)
constexpr int FFc = 5504;
__device__ __forceinline__ int tr_nmap(int kind, int n, int coff) {
    if (kind == 1) {
        const int pn = n >> 8, bj = (n >> 7) & 1, wc = (n >> 5) & 3, fq = (n >> 3) & 3, nn = (n >> 2) & 1, i = n & 3;
        return nn * FFc + 128 * pn + 32 * wc + 16 * bj + 4 * fq + i;
    }
    if (kind == 3) {
        if (n < 2048) return n;
        if (n < 4096) return 4096 + (n - 2048);
        if (n < 4112) return 6144 + (n - 4096);
        return -1;
    }
    return n + coff;
}
__device__ __forceinline__ int tr_kmap(int kind, int k) {
    if (kind == 2) return (k & ~31) | (((k >> 2) & 1) << 4) | (((k >> 3) & 3) << 2) | (k & 3);
    return k;
}
constexpr int I_UP = 256 * 43, I_DN = 688 * 8, I_AN = 256 * 17, I_SQ = 256 * 8, I_CV = 64 * 8;
constexpr int CV_B1 = I_UP;
constexpr int CV_B2 = CV_B1 + I_DN + I_AN + 2 * I_SQ + I_UP + I_DN;
constexpr int CV_B3 = CV_B2 + 2 * I_SQ + I_UP + I_DN + 2 * I_SQ;
constexpr int CV_END = CV_B3 + I_UP + I_DN + 8 * I_CV;
__device__ __forceinline__ void cv_item(ArgsP a, int it, int lane) {
    const float* W; unsigned char* ws = a->ws; bf16* WT; int ldw, ldt, nblk, kind = 0, coff = 0; int r = it;
#define CV_UP(m) { W = a->in[11] + (size_t)(m) * 2048 * 11008; ldw = 11008; ldt = 2048; nblk = 43; kind = 1; WT = (bf16*)(ws + WS_WUP + (size_t)(m) * SZ_WUP); }
#define CV_DN(m) { W = a->in[12] + (size_t)(m) * 5504 * 2048; ldw = 2048; ldt = 5504; nblk = 8; kind = 2; WT = (bf16*)(ws + WS_WDN + (size_t)(m) * SZ_WDN); }
#define CV_SQ(src, ld, co, dst) { W = (src); ldw = (ld); ldt = 2048; nblk = 8; coff = (co); WT = (bf16*)(ws + (dst)); }
    if (r < I_UP) CV_UP(0)
    else if ((r -= I_UP) < I_DN) CV_DN(0)
    else if ((r -= I_DN) < I_AN) { W = a->in[13]; ldw = 6160; ldt = 2048; nblk = 17; kind = 3; WT = (bf16*)(ws + WS_WAN); }
    else if ((r -= I_AN) < I_SQ) CV_SQ(a->in[13], 6160, 2048, WS_WAV)
    else if ((r -= I_SQ) < I_SQ) CV_SQ(a->in[17], 2048, 0, WS_WAO)
    else if ((r -= I_SQ) < I_UP) CV_UP(1)
    else if ((r -= I_UP) < I_DN) CV_DN(1)
    else if ((r -= I_DN) < I_SQ) CV_SQ(a->in[20], 4096, 0, WS_WK)
    else if ((r -= I_SQ) < I_SQ) CV_SQ(a->in[20], 4096, 2048, WS_WV)
    else if ((r -= I_SQ) < I_UP) CV_UP(2)
    else if ((r -= I_UP) < I_DN) CV_DN(2)
    else if ((r -= I_DN) < I_SQ) CV_SQ(a->in[21], 2048, 0, WS_WQ)
    else if ((r -= I_SQ) < I_SQ) CV_SQ(a->in[23], 2048, 0, WS_WBO)
    else if ((r -= I_SQ) < I_UP) CV_UP(3)
    else if ((r -= I_UP) < I_DN) CV_DN(3)
    else { r -= I_DN; const int b = r / I_CV; r -= b * I_CV; W = a->in[4] + (size_t)b * 512 * 2048; ldw = 2048; ldt = 512; nblk = 8; WT = (bf16*)(ws + WS_VTC + (size_t)b * 2048 * 512 * 2); }
#undef CV_UP
#undef CV_DN
#undef CV_SQ
    const int kb = r / nblk, nb = r - kb * nblk, k0 = 8 * kb, nrow = 256 * nb + 4 * lane;
    const int col = tr_nmap(kind, nrow, coff);
    f32x4 v[8];
#pragma unroll
    for (int e = 0; e < 8; ++e) { v[e] = (f32x4){0.f, 0.f, 0.f, 0.f}; if (col >= 0) v[e] = __builtin_nontemporal_load((const f32x4*)(W + (size_t)tr_kmap(kind, k0 + e) * ldw + col)); }
#pragma unroll
    for (int j = 0; j < 4; ++j) {
        const v4u o = {pk2(v[0][j], v[1][j]), pk2(v[2][j], v[3][j]), pk2(v[4][j], v[5][j]), pk2(v[6][j], v[7][j])};
        *(v4u*)(WT + (size_t)(nrow + j) * ldt + k0) = o; }
}
__device__ __forceinline__ void cv_gap(ArgsP a, int lo, int hi, int g, int per, bool flush, int gw, int NGW, int lane) {
    for (int j = 0; flush || j < per; ++j) {
        const int it = lo + (g * per + j) * NGW + gw;
        if (it >= hi) break;
        cv_item(a, it, lane);
    }
}
namespace pg8 {
#define PG8_LAS __attribute__((address_space(3)))
typedef unsigned short bf16_t;
typedef short bf16x8 __attribute__((ext_vector_type(8)));
typedef float f32x4 __attribute__((ext_vector_type(4)));
typedef unsigned u32x4 __attribute__((ext_vector_type(4)));
constexpr int BM = 256, BK = 64, HALF = 128, HTB = HALF * BK * 2  , STAGE_BYTES = 8 * HTB, NXCD = 8, WGM = PG8_WGM;

__host__ __device__ __forceinline__ int lds_byte(int r, int c) { const int st = (r >> 4) * 2 + (c >> 5), rr = r & 15, cc = c & 31, ob = rr * 64 + cc * 2; return st * 1024 + (ob ^ (((ob >> 9) & 1) << 5)); }
__host__ __device__ __forceinline__ void stage_rc(int b, int& R, int& C) { const int st = b / 1024, sb = b % 1024, swz = sb ^ (((sb >> 9) & 1) << 5); R = (st >> 1) * 16 + swz / 64; C = (st & 1) * 32 + (swz % 64) / 2; }
__host__ __device__ __forceinline__ int perm32(int rho) { const int n = rho >> 4, i = rho & 15; return 8 * (i >> 2) + 4 * n + (i & 3); }

struct Unit { int pm, pn; };
struct Gemm { const bf16_t* A; const bf16_t* Bt; int M, N, K; };

struct StaticOrder {
    int nM, nN, nwg, G, c;
    __host__ __device__ void init(int M, int N, int G_, int c_) { nM = M / BM; nN = N / BM; nwg = nM * nN; G = G_; c = c_; }
    __host__ __device__ bool next(int i, Unit& u) const {
        const long L = (long)i * G + c; if (L >= nwg) return false;
        int wgid = (int)L; { const int q = nwg / NXCD, r = nwg % NXCD, xcd = wgid % NXCD, off = wgid / NXCD; wgid = (xcd < r ? xcd * (q + 1) : r * (q + 1) + (xcd - r) * q) + off; }
        const int nig = WGM * nN, gid = wgid / nig, fm = gid * WGM, gsz = (nM - fm) < WGM ? (nM - fm) : WGM;
        u.pm = fm + ((wgid % nig) % gsz); u.pn = (wgid % nig) / gsz; return true;
    }
    __device__ __forceinline__ void a_ready(const Unit&) const {}
    __device__ __forceinline__ void done(const Unit&) const {}
};

__device__ __forceinline__ unsigned cvt_pk_bf16(float lo, float hi) { unsigned r; asm volatile("v_cvt_pk_bf16_f32 %0, %1, %2" : "=v"(r) : "v"(lo), "v"(hi)); return r; }
constexpr int E_D = 2048, E_TP = 16384, E_MR = 16512, E_MP = 16640, E_FF = 5504, E_ADA_LD = 40960;
typedef float f32x2 __attribute__((ext_vector_type(2)));
constexpr float E_ALPHA = 1.41421356237309515f;
__device__ __forceinline__ float silu_f(float a) { return a * __builtin_amdgcn_rcpf(1.0f + __expf(-a)); }
struct UnitX { int g, pm, pn, kt0, nkt; };
template <int NM0, int NN0, int NM1, int NN1, int NM2, int NN2, int NPCS, int PCS_NN, int NKT>
struct SegOrder {
    int G, c;
    static constexpr int C0 = NM0 * NN0, C1 = NM1 * NN1, C2 = NM2 * NN2, CP = NPCS * PCS_NN, TOT = C0 + C1 + C2 + CP;
    __device__ __forceinline__ bool next(int i, UnitX& u) const {
        int L = i * G + c; if (L >= TOT) return false;
        int g = 0, nM = NM0, nN = NN0; bool piece = false;
#if PG8_PIECES_FIRST
        if (CP > 0 && L < CP) { g = 3; piece = true; nM = 1; nN = 1; }
        else { L -= CP;
            if (L >= C0) { L -= C0; g = 1; nM = NM1; nN = NN1;
                if (L >= C1) { L -= C1; g = 2; nM = NM2; nN = NN2; } } }
#else
        if (L >= C0) { L -= C0; g = 1; nM = NM1; nN = NN1;
            if (L >= C1) { L -= C1; g = 2; nM = NM2; nN = NN2;
                if (L >= C2) { L -= C2; g = 3; piece = true; nM = 1; nN = 1; } } }
#endif
        constexpr int PNN = PCS_NN > 0 ? PCS_NN : 1;
        const int pc = L / PNN, ppn = L - pc * PNN;
        const int nwg = nM * nN;
        int wgid = piece ? 0 : L; { const int q = nwg / NXCD, r = nwg % NXCD, xcd = wgid % NXCD, off = wgid / NXCD; wgid = (xcd < r ? xcd * (q + 1) : r * (q + 1) + (xcd - r) * q) + off; }
        const int nig = WGM * nN, gid = wgid / nig, fm = gid * WGM, gsz = (nM - fm) < WGM ? (nM - fm) : WGM;
        const int pm_n = fm + ((wgid % nig) % gsz), pn_n = (wgid % nig) / gsz;
        u.g = g; u.pm = piece ? 64 : pm_n; u.pn = piece ? ppn : pn_n; u.kt0 = piece ? 4 * pc : 0; u.nkt = piece ? ((pc == NPCS - 1) ? NKT - 4 * (NPCS - 1) : 4) : NKT;
        return true;
    }
};
__device__ __forceinline__ void epi_up(const f32x4 (&acc)[2][2][4][2], const UnitX& u, int wr, int wc, int fr, int fq, bf16_t* Hd) {
    const int row0 = u.pm * BM + wr * 64 + fr, p0 = u.pn * 128 + wc * 32 + 8 * fq;
#pragma unroll
    for (int ai = 0; ai < 2; ++ai)
#pragma unroll
        for (int m = 0; m < 4; ++m) {
            const int row = row0 + ai * HALF + m * 16;
            const f32x4 a0 = acc[ai][0][m][0], u0 = acc[ai][0][m][1], a1 = acc[ai][1][m][0], u1 = acc[ai][1][m][1];
            u32x4 w;
            w.x = cvt_pk_bf16(silu_f(a0[0]) * u0[0], silu_f(a0[1]) * u0[1]); w.y = cvt_pk_bf16(silu_f(a0[2]) * u0[2], silu_f(a0[3]) * u0[3]);
            w.z = cvt_pk_bf16(silu_f(a1[0]) * u1[0], silu_f(a1[1]) * u1[1]); w.w = cvt_pk_bf16(silu_f(a1[2]) * u1[2], silu_f(a1[3]) * u1[3]);
            st16_wt(Hd + (size_t)row * E_FF + p0, w);
        }
}
template <int XMODE, int OUTF32>
__device__ __forceinline__ void epi_res(const f32x4 (&acc)[2][2][4][2], const UnitX& u, int wr, int wc, int fr, int fq, const void* xsrc, const float* stat, const float* lg, const float* lb, void* zdst, const float* gate, float s) {
    const int row0 = u.pm * BM + wr * 64 + fr, col0 = u.pn * BM + wc * 32 + 8 * fq;
    f32x4 g1[2][2], ag[2][2], ab[2][2];
#pragma unroll
    for (int bj = 0; bj < 2; ++bj)
#pragma unroll
        for (int n = 0; n < 2; ++n) { const int c = col0 + bj * HALF + 4 * n; g1[bj][n] = (*(const f32x4*)(gate + c) + 1.0f) * s;
            if (XMODE) { ag[bj][n] = *(const f32x4*)(lg + c) * E_ALPHA; ab[bj][n] = *(const f32x4*)(lb + c) * E_ALPHA; } }
#pragma unroll
    for (int ai = 0; ai < 2; ++ai)
#pragma unroll
        for (int m = 0; m < 4; ++m) {
            const int row = row0 + ai * HALF + m * 16; const size_t ro = (size_t)row * E_D;
            float mu = 0.f, rs = 1.f; if (XMODE) { const f32x2 st = *(const f32x2*)(stat + 2 * (size_t)row); mu = st.x; rs = st.y; }
#pragma unroll
            for (int bj = 0; bj < 2; ++bj) { const int c = col0 + bj * HALF;
                f32x4 z0, z1;
                if (XMODE) { const u32x4 w = *(const u32x4*)((const bf16_t*)xsrc + ro + c);
                    const f32x4 t0 = {__uint_as_float(w.x << 16), __uint_as_float(w.x & 0xffff0000u), __uint_as_float(w.y << 16), __uint_as_float(w.y & 0xffff0000u)};
                    const f32x4 t1 = {__uint_as_float(w.z << 16), __uint_as_float(w.z & 0xffff0000u), __uint_as_float(w.w << 16), __uint_as_float(w.w & 0xffff0000u)};
                    z0 = (t0 - mu) * rs * ag[bj][0] + ab[bj][0] + g1[bj][0] * acc[ai][bj][m][0];
                    z1 = (t1 - mu) * rs * ag[bj][1] + ab[bj][1] + g1[bj][1] * acc[ai][bj][m][1];
                } else { const f32x4 x0 = *(const f32x4*)((const float*)xsrc + ro + c), x1 = *(const f32x4*)((const float*)xsrc + ro + c + 4);
                    z0 = x0 * E_ALPHA + g1[bj][0] * acc[ai][bj][m][0]; z1 = x1 * E_ALPHA + g1[bj][1] * acc[ai][bj][m][1]; }
                if (OUTF32) { *(f32x4*)((float*)zdst + ro + c) = z0; *(f32x4*)((float*)zdst + ro + c + 4) = z1; }
                else { u32x4 w; w.x = cvt_pk_bf16(z0[0], z0[1]); w.y = cvt_pk_bf16(z0[2], z0[3]); w.z = cvt_pk_bf16(z1[0], z1[1]); w.w = cvt_pk_bf16(z1[2], z1[3]); st16_wt((bf16_t*)zdst + ro + c, w); }
            }
            asm volatile("" ::: "memory");
        }
}
__device__ __forceinline__ void epi_part(const f32x4 (&acc)[2][2][4][2], const UnitX& u, int wr, int wc, int fr, int fq, float* ZSP) {
    const int r0 = wr * 64 + fr, col0 = u.pn * BM + wc * 32 + 8 * fq; float* base = ZSP + (size_t)(u.kt0 >> 2) * 128 * E_D;
#pragma unroll
    for (int m = 0; m < 4; ++m) {
        float* zr = base + (size_t)(r0 + m * 16) * E_D;
#pragma unroll
        for (int bj = 0; bj < 2; ++bj)
#pragma unroll
            for (int n = 0; n < 2; ++n) st16_wt(zr + col0 + bj * HALF + 4 * n, acc[0][bj][m][n]);
    }
}
__device__ __forceinline__ void epi_b16(const f32x4 (&acc)[2][2][4][2], const UnitX& u, int wr, int wc, int fr, int fq, bf16_t* O, int ldc, int colt, float sc) {
    const int row0 = u.pm * BM + wr * 64 + fr, col0 = colt + wc * 32 + 8 * fq;
#pragma unroll
    for (int ai = 0; ai < 2; ++ai)
#pragma unroll
        for (int m = 0; m < 4; ++m) {
            const int row = row0 + ai * HALF + m * 16;
#pragma unroll
            for (int bj = 0; bj < 2; ++bj) {
                const f32x4 v0 = acc[ai][bj][m][0] * sc, v1 = acc[ai][bj][m][1] * sc;
                u32x4 w; w.x = cvt_pk_bf16(v0[0], v0[1]); w.y = cvt_pk_bf16(v0[2], v0[3]); w.z = cvt_pk_bf16(v1[0], v1[1]); w.w = cvt_pk_bf16(v1[2], v1[3]);
                st16_wt(O + (size_t)row * ldc + col0 + bj * HALF, w);
            }
        }
}
__device__ __forceinline__ void epi_vtblk(const f32x4 (&acc)[2][2][4][2], const UnitX& u, int wr, int wc, int fr, int fq, bf16_t* O) {
    const int row0 = u.pm * BM + wr * 64 + fr, col0 = u.pn * BM + wc * 32 + 8 * fq;
#pragma unroll
    for (int ai = 0; ai < 2; ++ai)
#pragma unroll
        for (int m = 0; m < 4; ++m) {
            const int row = row0 + ai * HALF + m * 16;
#pragma unroll
            for (int bj = 0; bj < 2; ++bj) {
                const f32x4 v0 = acc[ai][bj][m][0], v1 = acc[ai][bj][m][1]; const int col = col0 + bj * HALF;
                u32x4 w; w.x = cvt_pk_bf16(v0[0], v0[1]); w.y = cvt_pk_bf16(v0[2], v0[3]); w.z = cvt_pk_bf16(v1[0], v1[1]); w.w = cvt_pk_bf16(v1[2], v1[3]);
                st16_wt(O + ((size_t)(col >> 6) * 2048 + row) * 64 + (col & 63), w);
            }
        }
}
__device__ __forceinline__ void epi_kout(const f32x4 (&acc)[2][2][4][2], const UnitX& u, int wr, int wc, int fr, int fq, float* fp, int fdelta) {
    if (u.pm < 62) return;
    const int row0 = u.pm * BM + wr * 64 + fr, col0 = u.pn * BM + wc * 32 + 8 * fq;
#pragma unroll
    for (int ai = 0; ai < 2; ++ai)
#pragma unroll
        for (int m = 0; m < 4; ++m) {
            const int row = row0 + ai * HALF + m * 16;
            if (row < E_MR) {
                float* dst = fp + (row < E_TP ? (size_t)(row - (E_TP - 512)) * E_D : (size_t)fdelta + (size_t)(row - E_TP) * E_D);
#pragma unroll
                for (int bj = 0; bj < 2; ++bj) { *(f32x4*)(dst + col0 + bj * HALF) = acc[ai][bj][m][0]; *(f32x4*)(dst + col0 + bj * HALF + 4) = acc[ai][bj][m][1]; }
            }
        }
}
__device__ __forceinline__ void epi_vout(const f32x4 (&acc)[2][2][4][2], const UnitX& u, int wr, int wc, int fr, int fq, float* fp, int fdelta) {
    if (u.pn < 62) return;
    const int row0 = u.pm * BM + wr * 64 + fr, col0 = u.pn * BM + wc * 32 + 8 * fq;
#pragma unroll
    for (int ai = 0; ai < 2; ++ai)
#pragma unroll
        for (int m = 0; m < 4; ++m) {
            const int row = row0 + ai * HALF + m * 16;
#pragma unroll
            for (int bj = 0; bj < 2; ++bj)
#pragma unroll
                for (int j = 0; j < 8; ++j) { const int t = col0 + bj * HALF + j; const float v = j < 4 ? acc[ai][bj][m][0][j & 3] : acc[ai][bj][m][1][j & 3];
                    if (t < E_MR) fp[(t < E_TP ? (size_t)(t - (E_TP - 512)) * E_D : (size_t)fdelta + (size_t)(t - E_TP) * E_D) + row] = v; }
        }
}
#define OPS_AP ArgsP ap = a; asm volatile("" : "+s"(ap))
template <size_t WOFF, int CVLO, int CVHI, int CVPER> struct OpsUp {
    static constexpr int KROW = E_D; ArgsP a; int G;
    __device__ __forceinline__ void gap(int ui, bool last, int tid) const { if (CVHI > CVLO) { OPS_AP; cv_gap(ap, CVLO, CVHI, ui, CVPER, last, (int)blockIdx.x * 8 + (tid >> 6), G * 8, tid & 63); } }
    __device__ __forceinline__ const char* abase(int) const { return (const char*)(a->ws + WS_H); }
    __device__ __forceinline__ const char* bbase(int) const { return (const char*)(a->ws + WOFF); }
    __device__ __forceinline__ bool btiled(int) const { return W_TILED != 0; }
    __device__ __forceinline__ void operator()(const f32x4 (&acc)[2][2][4][2], const UnitX& u, int wr, int wc, int fr, int fq) const { OPS_AP; epi_up(
acc, u, wr, wc, fr, fq, (bf16_t*)(ap->ws + WS_HID)); }
};
template <size_t AOFF, size_t WOFF, int KR, int SUB, int GOFF, int SHALF> struct OpsRes {
    static constexpr int KROW = KR; ArgsP a; int G;
    __device__ __forceinline__ void gap(int, bool, int) const {}
    __device__ __forceinline__ const char* abase(int) const { return (const char*)(a->ws + AOFF); }
    __device__ __forceinline__ const char* bbase(int) const { return (const char*)(a->ws + WOFF); }
    __device__ __forceinline__ bool btiled(int) const { return W_TILED != 0; }
    __device__ __forceinline__ void operator()(const f32x4 (&acc)[2][2][4][2], const UnitX& u, int wr, int wc, int fr, int fq) const { OPS_AP;
        if (u.g == 0) {
            const void* xsrc = SUB == 0 ? (const void*)ap->in[0] : (const void*)(ap->ws + (((SUB - 1) & 1) ? WS_ZB1 : WS_ZB0));
            void* zdst = (void*)(ap->ws + ((SUB & 1) ? WS_ZB1 : WS_ZB0));
            constexpr int PS = SUB > 0 ? SUB - 1 : 0;
            epi_res<(SUB > 0), 0>(acc, u, wr, wc, fr, fq, xsrc, (const float*)(ap->ws + WS_STAT), ap->in[9] + PS * E_D, ap->in[10] + PS * E_D, zdst, (const float*)(ap->ws + WS_ADA) + GOFF, SHALF ? 0.5f : 1.0f);
        } else epi_part(acc, u, wr, wc, fr, fq, (float*)(ap->ws + WS_ZSP)); }
};
struct OpsAin {
    static constexpr int KROW = E_D; ArgsP a; int G;
    __device__ __forceinline__ void gap(int, bool, int) const {}
    __device__ __forceinline__ const char* abase(int g) const { return (const char*)(a->ws + (g == 0 ? WS_H : WS_WAV)); }
    __device__ __forceinline__ const char* bbase(int g) const { return (const char*)(a->ws + (g == 0 ? WS_WAN : WS_H)); }
    __device__ __forceinline__ bool btiled(int g) const { return W_TILED != 0 && g == 0; }
    __device__ __forceinline__ void operator()(const f32x4 (&acc)[2][2][4][2], const UnitX& u, int wr, int wc, int fr, int fq) const { OPS_AP;
#if VT_BLOCKED
        if (u.g == 1) { epi_vtblk(acc, u, wr, wc, fr, fq, (bf16_t*)(ap->ws + WS_VTG)); return; }
#else
        if (u.g == 1) { epi_b16(acc, u, wr, wc, fr, fq, (bf16_t*)(ap->ws + WS_VTG), E_MP, u.pn * BM, 1.0f); return; }
#endif
        const int pn = u.pn;
        if (pn < 4) epi_b16(acc, u, wr, wc, fr, fq, (bf16_t*)(ap->ws + WS_QG), 1024, pn * BM, 0.0625f);
        else if (pn < 8) epi_b16(acc, u, wr, wc, fr, fq, (bf16_t*)(ap->ws + WS_KG), 1024, (pn - 4) * BM, 1.0f);
        else if (pn < 16) epi_b16(acc, u, wr, wc, fr, fq, (bf16_t*)(ap->ws + WS_GG), 2048, (pn - 8) * BM, 1.0f);
        else if (wc == 0 && fq < 2) { float* GKL = (float*)(ap->ws + WS_GKL); const int row0 = u.pm * BM + wr * 64 + fr;
#pragma unroll
            for (int ai = 0; ai < 2; ++ai)
#pragma unroll
                for (int m = 0; m < 4; ++m) { float* dst = GKL + (size_t)(row0 + ai * HALF + m * 16) * 16 + 8 * fq; *(f32x4*)dst = acc[ai][0][m][0]; *(f32x4*)(dst + 4) = acc[ai][0][m][1]; } }
    }
};
template <size_t WUPOFF, int CVLO, int CVHI, int CVPER> struct OpsKVUp {
    static constexpr int KROW = E_D; ArgsP a; int G;
    __device__ __forceinline__ void gap(int ui, bool last, int tid) const { if (CVHI > CVLO) { OPS_AP; cv_gap(ap, CVLO, CVHI, ui, CVPER, last, (int)blockIdx.x * 8 + (tid >> 6), G * 8, tid & 63); } }
    __device__ __forceinline__ const char* abase(int g) const { return (const char*)(a->ws + (g == 0 ? WS_H2 : (g == 1 ? WS_WV : WS_H))); }
    __device__ __forceinline__ const char* bbase(int g) const { return (const char*)(a->ws + (g == 0 ? WS_WK : (g == 1 ? WS_H2 : WUPOFF))); }
    __device__ __forceinline__ bool btiled(int g) const { return W_TILED != 0 && g != 1; }
    __device__ __forceinline__ void operator()(const f32x4 (&acc)[2][2][4][2], const UnitX& u, int wr, int wc, int fr, int fq) const { OPS_AP;
        if (u.g == 2) epi_up(acc, u, wr, wc, fr, fq, (bf16_t*)(ap->ws + WS_HID));
        else if (u.g == 0) { epi_b16(acc, u, wr, wc, fr, fq, (bf16_t*)(ap->ws + WS_KB), E_D, u.pn * BM, 1.0f); epi_kout(acc, u, wr, wc, fr, fq, ap->out + O_KP, (int)(O_KS - O_KP)); }
        else { epi_b16(acc, u, wr, wc, fr, fq, (bf16_t*)(ap->ws + WS_VTB), E_MP, u.pn * BM, 1.0f); epi_vout(acc, u, wr, wc, fr, fq, ap->out + O_VP, (int)(O_VS - O_VP)); } }
};
struct OpsQ {
    static constexpr int KROW = E_D; ArgsP a; int G;
    __device__ __forceinline__ void gap(int, bool, int) const {}
    __device__ __forceinline__ const char* abase(int) const { return (const char*)(a->ws + WS_H); }
    __device__ __forceinline__ const char* bbase(int) const { return (const char*)(a->ws + WS_WQ); }
    __device__ __forceinline__ bool btiled(int) const { return W_TILED != 0; }
    __device__ __forceinline__ void operator()(const f32x4 (&acc)[2][2][4][2], const UnitX& u, int wr, int wc, int fr, int fq) const { OPS_AP;
        if (u.g == 0) epi_b16(acc, u, wr, wc, fr, fq, (bf16_t*)(ap->ws + WS_H2), E_D, u.pn * BM, 1.0f);
        else epi_part(acc, u, wr, wc, fr, fq, (float*)(ap->ws + WS_ZSP)); }
};
template <class Ops, class Sched>
__device__ __forceinline__ void gemm_phase2(PG8_LAS unsigned char* lds, const Sched& S, const Ops& E, const bool skip_epi = false) {
    constexpr bool ALIGN_EPI = PG8_ALIGN_EPI, SP2 = PG8_SP2;
    const int tid = fresh_tid(), wid = __builtin_amdgcn_readfirstlane(tid >> 6), lane = tid & 63, wr = wid >> 2, wc = wid & 3, fr = lane & 15, fq = lane >> 4;
    constexpr int K = Ops::KROW;
    unsigned voffA[2], voffB[2], voffBt[2];
#pragma unroll
    for (int i = 0; i < 2; ++i) { int R, C; stage_rc(tid * 16 + i * 8192, R, C); const int Rb = (R & ~31) + perm32(R & 31);
        voffA[i] = (unsigned)(R * K + C) * 2u; voffB[i] = (unsigned)(Rb * K + C) * 2u; voffBt[i] = (unsigned)(Rb * BK + C) * 2u; }
    const size_t kstep = (size_t)(BK * 2);
    const size_t hstep = (size_t)HALF * K * 2;
    const size_t tstep = 2 * hstep;
    constexpr size_t kstepT = (size_t)256 * BK * 2, hstepT = (size_t)HALF * BK * 2, tstepT = (size_t)(K / BK) * kstepT;
#define PG8_BT(g_) (E.btiled(g_))
#define PG8_BADDR(u_) (E.bbase((u_).g) + (size_t)(u_).pn * (PG8_BT((u_).g) ? tstepT : tstep) + (size_t)(u_).kt0 * (PG8_BT((u_).g) ? kstepT : kstep))
    const unsigned ldsw = (unsigned)wid * 1024u;
    const int aoff = lds_byte(wr * 64 + fr, fq * 8), boff = lds_byte(wc * 32 + fr, fq * 8);
#define PG8_SA(b, h) (((b) * 2 + (h)) * HTB)
#define PG8_SB(b, h) ((4 + (b) * 2 + (h)) * HTB)
#define PG8_STAGE(bufoff, gbase, voff) do { _Pragma("unroll") for (int _i = 0; _i < 2; ++_i) \
        __builtin_amdgcn_global_load_lds((const unsigned*)((const char*)(gbase) + (voff)[_i]), (PG8_LAS unsigned*)(lds + (bufoff) + ldsw + _i * 8192), 16, 0, 0); } while (0)
#define PG8_LDA(dst, b, h) do { _Pragma("unroll") for (int m = 0; m < 4; ++m) _Pragma("unroll") for (int k = 0; k < 2; ++k) dst[m][k] = *(const PG8_LAS bf16x8*)(lds + PG8_SA(b, h) + aoff + m * 2048 + k * 1024); } while (0)
#define PG8_LDB(dst, b, h) do { _Pragma("unroll") for (int n = 0; n < 2; ++n) _Pragma("unroll") for (int k = 0; k < 2; ++k) dst[n][k] = *(const PG8_LAS bf16x8*)(lds + PG8_SB(b, h) + boff + n * 2048 + k * 1024); } while (0)
#define PG8_MMA(ai, bj, At, Bt) do { __builtin_amdgcn_s_setprio(1); _Pragma("unroll") for (int m = 0; m < 4; ++m) _Pragma("unroll") for (int n = 0; n < 2; ++n) _Pragma("unroll") for (int k = 0; k < 2; ++k) \
        acc[ai][bj][m][n] = __builtin_amdgcn_mfma_f32_16x16x32_bf16(Bt[n][k], At[m][k], acc[ai][bj][m][n], 0, 0, 0); __builtin_amdgcn_s_setprio(0); } while (0)
#define PG8_WAIT_V(n) asm volatile("s_waitcnt vmcnt(" #n ")" ::: "memory")
#define PG8_WAIT_L(n) asm volatile("s_waitcnt lgkmcnt(" #n ")" ::: "memory")
#define PG8_BAR __builtin_amdgcn_s_barrier()
#define PG8_SCHED __builtin_amdgcn_sched_barrier(0)
    UnitX cur, nxt; int ui = 0;
    if (!S.next(0, cur)) return;
    f32x4 acc[2][2][4][2];
#pragma unroll
    for (int a = 0; a < 2; ++a)
#pragma unroll
        for (int b = 0; b < 2; ++b)
#pragma unroll
            for (int m = 0; m < 4; ++m)
#pragma unroll
                for (int n = 0; n < 2; ++n) acc[a][b][m][n] = (f32x4){0.f, 0.f, 0.f, 0.f};
    bf16x8 At[4][2], B0[2][2], B1[2][2];
    const char* cA = E.abase(cur.g) + (size_t)cur.pm * tstep + (size_t)cur.kt0 * kstep; const char* cB = PG8_BADDR(cur);
    { const bool bt0_ = PG8_BT(cur.g); const size_t hB = bt0_ ? hstepT : hstep, kB = bt0_ ? kstepT : kstep; unsigned vB[2] = {bt0_ ? voffBt[0] : voffB[0], bt0_ ? voffBt[1] : voffB[1]};
    if constexpr (SP2) {
        PG8_STAGE(PG8_SB(0, 0), cB, vB); PG8_STAGE(PG8_SB(0, 1), cB + hB, vB); PG8_STAGE(PG8_SA(0, 0), cA, voffA); PG8_STAGE(PG8_SA(0, 1), cA + hstep, voffA);
        if (wr == 1) PG8_BAR;
        PG8_WAIT_V(2); PG8_BAR;
        PG8_STAGE(PG8_SB(1, 0), cB + kB, vB); PG8_STAGE(PG8_SA(1, 0), cA + kstep, voffA); PG8_STAGE(PG8_SB(1, 1), cB + hB + kB, vB);
        PG8_WAIT_V(6); PG8_BAR;
    } else {
        PG8_STAGE(PG8_SB(0, 0), cB, vB); PG8_STAGE(PG8_SA(0, 0), cA, voffA); PG8_STAGE(PG8_SB(0, 1), cB + hB, vB); PG8_STAGE(PG8_SA(0, 1), cA + hstep, voffA);
        if (wr == 1) PG8_BAR;
        PG8_WAIT_V(4); PG8_BAR;
        PG8_STAGE(PG8_SB(1, 0), cB + kB, vB); PG8_STAGE(PG8_SA(1, 0), cA + kstep, voffA); PG8_STAGE(PG8_SB(1, 1), cB + hB + kB, vB);
        PG8_WAIT_V(6); PG8_BAR;
    } }
    for (;;) {
        const bool has_next = S.next(ui + 1, nxt);
        const char* nA = cA; const char* nB = cB; if (has_next) { nA = E.abase(nxt.g) + (size_t)nxt.pm * tstep + (size_t)nxt.kt0 * kstep; nB = PG8_BADDR(nxt); }
        const bool btc = PG8_BT(cur.g), btn = has_next ? PG8_BT(nxt.g) : btc;
        const int nt = cur.nkt;
        for (int t = 0; t < nt; t += 2) {
            const bool last = (t == nt - 2);
            const char* a1 = cA + (size_t)(t + 1) * kstep;
            const bool bto = last ? btn : btc; const size_t hB = bto ? hstepT : hstep, kB = bto ? kstepT : kstep; unsigned vB[2] = {bto ? voffBt[0] : voffB[0], bto ? voffBt[1] : voffB[1]};
            const char* a2 = last ? nA : cA + (size_t)(t + 2) * kstep; const char* b2 = last ? nB : cB + (size_t)(t + 2) * kB;
            const char* a3 = a2 + kstep; const char* b3 = b2 + kB;
            if constexpr (SP2) {
            PG8_LDB(B0, 0, 0); PG8_LDB(B1, 0, 1); PG8_SCHED; PG8_LDA(At, 0, 0); PG8_STAGE(PG8_SA(1, 1), a1 + hstep, voffA);
            PG8_WAIT_V(8); PG8_WAIT_L(0); PG8_BAR; PG8_MMA(0, 0, At, B0); PG8_MMA(0, 1, At, B1); PG8_BAR; PG8_SCHED;
            PG8_LDA(At, 0, 1); PG8_STAGE(PG8_SB(0, 0), b2, vB); PG8_STAGE(PG8_SB(0, 1), b2 + hB, vB); PG8_STAGE(PG8_SA(0, 0), a2, voffA);
            PG8_WAIT_V(8); PG8_WAIT_L(0); PG8_BAR; PG8_MMA(1, 0, At, B0); PG8_MMA(1, 1, At, B1); PG8_BAR; PG8_SCHED;
            PG8_LDB(B0, 1, 0); PG8_LDB(B1, 1, 1); PG8_SCHED; PG8_LDA(At, 1, 0); PG8_STAGE(PG8_SA(0, 1), a2 + hstep, voffA);
            PG8_WAIT_V(8); PG8_WAIT_L(0); PG8_BAR; PG8_MMA(0, 0, At, B0); PG8_MMA(0, 1, At, B1); PG8_BAR; PG8_SCHED;
            PG8_LDA(At, 1, 1); PG8_STAGE(PG8_SB(1, 0), b3, vB); PG8_STAGE(PG8_SB(1, 1), b3 + hB, vB); PG8_STAGE(PG8_SA(1, 0), a3, voffA);
            PG8_WAIT_V(8); PG8_WAIT_L(0); PG8_BAR; PG8_MMA(1, 0, At, B0); PG8_MMA(1, 1, At, B1); PG8_BAR; PG8_SCHED;
            } else {
            PG8_LDB(B0, 0, 0); PG8_SCHED; PG8_LDA(At, 0, 0); PG8_STAGE(PG8_SA(1, 1), a1 + hstep, voffA);
            PG8_WAIT_L(8); PG8_BAR; PG8_WAIT_L(0); PG8_MMA(0, 0, At, B0); PG8_BAR; PG8_SCHED;
            PG8_LDB(B1, 0, 1); PG8_STAGE(PG8_SB(0, 0), b2, vB);
            PG8_BAR; PG8_WAIT_L(0); PG8_MMA(0, 1, At, B1); PG8_BAR;
            PG8_LDA(At, 0, 1); PG8_STAGE(PG8_SA(0, 0), a2, voffA);
            PG8_BAR; PG8_WAIT_L(0); PG8_MMA(1, 0, At, B0); PG8_BAR; PG8_SCHED;
            PG8_STAGE(PG8_SB(0, 1), b2 + hB, vB);
            PG8_WAIT_V(6); PG8_BAR; PG8_MMA(1, 1, At, B1); PG8_BAR;
            PG8_LDB(B0, 1, 0); PG8_SCHED; PG8_LDA(At, 1, 0); PG8_STAGE(PG8_SA(0, 1), a2 + hstep, voffA);
            PG8_WAIT_L(8); PG8_BAR; PG8_WAIT_L(0); PG8_MMA(0, 0, At, B0); PG8_BAR; PG8_SCHED;
            PG8_LDB(B1, 1, 1); PG8_STAGE(PG8_SB(1, 0), b3, vB);
            PG8_BAR; PG8_WAIT_L(0); PG8_MMA(0, 1, At, B1); PG8_BAR;
            PG8_LDA(At, 1, 1); PG8_STAGE(PG8_SA(1, 0), a3, voffA);
            PG8_BAR; PG8_WAIT_L(0); PG8_MMA(1, 0, At, B0); PG8_BAR; PG8_SCHED;
            PG8_STAGE(PG8_SB(1, 1), b3 + hB, vB);
            PG8_WAIT_V(6); PG8_BAR; PG8_MMA(1, 1, At, B1); PG8_BAR;
            }
        }
        if constexpr (ALIGN_EPI) { if (wr == 0) PG8_BAR; }
        { int tid2; asm volatile("v_mov_b32 %0, %1" : "=v"(tid2) : "v"(tid));
            if (!skip_epi) E(acc, cur, wr, wc, tid2 & 15, (tid2 >> 4) & 3);
            else { _Pragma("unroll") for (int a_ = 0; a_ < 2; ++a_) _Pragma("unroll") for (int b_ = 0; b_ < 2; ++b_) _Pragma("unroll") for (int m_ = 0; m_ < 4; ++m_) _Pragma("unroll") for (int n_ = 0; n_ < 2; ++n_) asm volatile("" :: "v"(acc[a_][b_][m_][n_])); } }
        E.gap(ui, !has_next, tid);
        if (!has_next) break;
#pragma unroll
        for (int a = 0; a < 2; ++a)
#pragma unroll
            for (int b = 0; b < 2; ++b)
#pragma unroll
                for (int m = 0; m < 4; ++m)
#pragma unroll
                    for (int n = 0; n < 2; ++n) acc[a][b][m][n] = (f32x4){0.f, 0.f, 0.f, 0.f};
        cur = nxt; cA = nA; cB = nB; ++ui;
        if constexpr (ALIGN_EPI) { if (wr == 1) PG8_BAR; }
    }
    PG8_WAIT_V(0);
    if constexpr (!ALIGN_EPI) { if (wr == 0) PG8_BAR; }
    PG8_BAR;
#undef PG8_BT
#undef PG8_BADDR
#undef PG8_SA
#undef PG8_SB
#undef PG8_STAGE
#undef PG8_LDA
#undef PG8_LDB
#undef PG8_MMA
#undef PG8_WAIT_V
#undef PG8_WAIT_L
#undef PG8_BAR
#undef PG8_SCHED
}
}
#define XB_TMO      128
#define XB_XCNT(j)  (256  + 64 * (j))
#define XB_XSUB(j)  (1280 + 64 * (j))
#define XB_XGEN(j)  (2304 + 64 * (j))
#define XB_TOP      3328
#define XB_TOPGEN   3392
#define XCD_BAR_WORDS 3456
#define XB_SPIN_CAP (1u << 18)

__device__ __forceinline__ unsigned xb_ld(unsigned* p)              { return __hip_atomic_load(p, __ATOMIC_RELAXED, __HIP_MEMORY_SCOPE_AGENT); }
__device__ __forceinline__ unsigned xb_add(unsigned* p, unsigned v) { return __hip_atomic_fetch_add(p, v, __ATOMIC_RELAXED, __HIP_MEMORY_SCOPE_AGENT); }
__device__ __forceinline__ unsigned xb_xcc_id() { return (unsigned)__builtin_amdgcn_s_getreg((3 << 11) | 20) & 0xFu; }
#define XB_SPIN(cond, bar) do { unsigned _sp = 0; while (cond) { __builtin_amdgcn_s_sleep(1); \
    if ((++_sp & 255u) == 0u) { if (xb_ld(&(bar)[XB_TMO])) break; if (_sp > XB_SPIN_CAP) { atomicAdd(&(bar)[XB_TMO], 1u); break; } } } } while (0)

struct XcdBarrier {
    unsigned* bar; unsigned x;
    volatile LAS unsigned* st;
};

__device__ __forceinline__ XcdBarrier xcd_barrier_post(unsigned* bar, volatile LAS unsigned* st) {
    XcdBarrier b; b.bar = bar; b.x = xb_xcc_id(); b.st = st;
    if (threadIdx.x == 0) (void)xb_add(&bar[XB_XCNT(b.x)], 1u);
    return b;
}
__device__ __forceinline__ void xcd_barrier_complete(unsigned* bar, unsigned x, unsigned& nloc, unsigned& nx) {
    const unsigned G = gridDim.x * gridDim.y * gridDim.z;
    unsigned sum, cnt, mine, sp = 0u;
    for (;;) {
        sum = 0u; cnt = 0u; mine = 0u;
#pragma unroll
        for (unsigned j = 0; j < 16; ++j) { const unsigned c = xb_ld(&bar[XB_XCNT(j)]); sum += c; cnt += (c > 0u) ? 1u : 0u; mine = (j == x) ? c : mine; }
        if (sum == G) break;
        __builtin_amdgcn_s_sleep(1);
        if ((++sp & 255u) == 0u) { if (xb_ld(&bar[XB_TMO])) break; if (sp > XB_SPIN_CAP) { atomicAdd(&bar[XB_TMO], 1u); break; } }
    }
    nloc = mine > 0u ? mine : 1u; nx = cnt > 0u ? cnt : 1u;
}

__device__ __forceinline__ void xcd_barrier(const XcdBarrier& b) {
    asm volatile("s_waitcnt vmcnt(0)" ::: "memory");
    __syncthreads();
    if (threadIdx.x == 0) {
        unsigned* bar = b.bar;
        __builtin_amdgcn_s_waitcnt(0);
        unsigned nloc = b.st[0], nx = b.st[1];
        if (nloc == 0u) { xcd_barrier_complete(bar, b.x, nloc, nx); b.st[0] = nloc; b.st[1] = nx; }
        const unsigned old = xb_add(&bar[XB_XSUB(b.x)], 1u);
        const unsigned gen = old / nloc;
        if (old + 1u == (gen + 1u) * nloc) {
            __builtin_amdgcn_fence(__ATOMIC_RELEASE, "agent");
            asm volatile("s_waitcnt vmcnt(0)" ::: "memory");
            const unsigned og = xb_add(&bar[XB_TOP], 1u);
            const unsigned tg = og / nx;
            if (og + 1u == (tg + 1u) * nx) xb_add(&bar[XB_TOPGEN], 1u);
            else XB_SPIN(xb_ld(&bar[XB_TOPGEN]) == tg, bar);
            __builtin_amdgcn_fence(__ATOMIC_ACQUIRE, "agent");
            xb_add(&bar[XB_XGEN(b.x)], 1u);
            asm volatile("s_waitcnt vmcnt(0)" ::: "memory");
        } else {
            XB_SPIN(xb_ld(&bar[XB_XGEN(b.x)]) == gen, bar);
            __builtin_amdgcn_fence(__ATOMIC_ACQUIRE, "agent");
            asm volatile("s_waitcnt vmcnt(0)" ::: "memory");
        }
    }
    __syncthreads();
}
#ifndef CV_TILED_KPAIR
#define CV_TILED_KPAIR 1
#endif
#ifndef ADA_DBN
#define ADA_DBN 8
#endif
#ifndef CV_KPAIR
#define CV_KPAIR 1
#endif
#ifndef ADA_DB
#define ADA_DB 1
#endif
#ifndef ADA_ILV
#define ADA_ILV 0
#endif
#ifndef ADA_UNR
#define ADA_UNR 8
#endif
#ifndef LN_SPRE
#define LN_SPRE 0
#endif
#ifndef LN_SREP
#define LN_SREP 1
#endif
#ifndef G2_SPLIT
#define G2_SPLIT 1
#endif
struct Frame {
    LAS unsigned char* lds;
    int vcu, G;
    ArgsP a;
};
#define F_IN(i) (F.a->in[i])
#define F_WS (F.a->ws)
#define F_OUT (F.a->out)
#define F_ADA ((float*)(F.a->ws + WS_ADA))
#define IN_XP 0
#define IN_XS 1
#define IN_STATE 2
#define IN_CK 3
#define IN_CV 4
#define IN_CP 5
#define IN_CS 6
#define IN_WADA 7
#define IN_BADA 8
#define IN_LNG 9
#define IN_LNB 10
#define IN_WUP 11
#define IN_WDN 12
#define IN_WAIN 13
#define IN_WGK2 14
#define IN_BGK 15
#define IN_GNORM 16
#define IN_WAOUT 17
#define IN_WADAKV 18
#define IN_BADAKV 19
#define IN_WKV 20
#define IN_WBQ 21
#define IN_REL 22
#define IN_WBO 23

struct TrItem { const float* W; bf16* WT; int ldw, ldt, kind, coff, k0, n0, tiled; };
__device__ __forceinline__ void tr_load(const TrItem& t, float (&v)[32], int lane) {
    const int nn = lane & 31; const int col = tr_nmap(t.kind, t.n0 + nn, t.coff);
#pragma unroll
    for (int i = 0; i < 32; ++i) { const int kk = 2 * i + (lane >> 5); v[i] = 0.f; if (col >= 0) v[i] = t.W[(size_t)tr_kmap(t.kind, t.k0 + kk) * t.ldw + col]; }
}
__device__ __forceinline__ void tr_store(const TrItem& t, const float (&v)[32], LAS float* scr, int lane) {
    const int nn = lane & 31;
#pragma unroll
    for (int i = 0; i < 32; ++i) { const int kk = 2 * i + (lane >> 5); scr[kk * 33 + nn] = v[i]; }
    LDS_WAIT(); asm volatile("" ::: "memory");
    const int c = lane & 7;
#pragma unroll
    for (int j = 0; j < 4; ++j) { const int n = (lane >> 3) + 8 * j; const LAS float* s = scr + (8 * c) * 33 + n;
        v4u o; o.x = pk2(s[0 * 33], s[1 * 33]); o.y = pk2(s[2 * 33], s[3 * 33]); o.z = pk2(s[4 * 33], s[5 * 33]); o.w = pk2(s[6 * 33], s[7 * 33]);
        const int nr_ = t.n0 + n;
        bf16* dst_ = t.tiled ? t.WT + ((((size_t)(nr_ >> 8) * (t.ldt >> 6) + (t.k0 >> 6)) * 256 + (nr_ & 255)) << 6) + 8 * c : t.WT + (size_t)nr_ * t.ldt + t.k0 + 8 * c;
        st16_wt(dst_, o); }
    LDS_WAIT(); asm volatile("" ::: "memory");
}
__device__ __forceinline__ void p0_convert(Frame& F) {
    const int tid_ = fresh_tid(), lane_ = tid_ & 63, wave_ = __builtin_amdgcn_readfirstlane(tid_ >> 6); (void)lane_; (void)wave_;
    LAS float* scr = (LAS float*)(F.lds + wave_ * 16384);
    const int gw = F.vcu * NWAVES + wave_, NGW = F.G * NWAVES;
    constexpr int I_UP = 32 * 344, I_DN = 86 * 64, I_AN = 32 * 136, I_SQ = 32 * 64, I_CV = 8 * 64;
    constexpr int NITEMS = 4 * I_UP + 4 * I_DN + I_AN + 6 * I_SQ + 8 * I_CV;
    auto decode = [&](int it, TrItem& t) {
        unsigned char* ws = F_WS; int r = it; int nblk; t.kind = 0; t.coff = 0; t.tiled = W_TILED;
        if (r < 4 * I_UP) { const int m = r / I_UP; r -= m * I_UP; t.W = F_IN(IN_WUP) + (size_t)m * D * FF2; t.ldw = FF2; t.ldt = D; nblk = 344; t.kind = 1; t.WT = (bf16*)(ws + WS_WUP + (size_t)m * SZ_WUP); }
        else if ((r -= 4 * I_UP) < 4 * I_DN) { const int m = r / I_DN; r -= m * I_DN; t.W = F_IN(IN_WDN) + (size_t)m * FF * D; t.ldw = D; t.ldt = FF; nblk = 64; t.kind = 2; t.WT = (bf16*)(ws + WS_WDN + (size_t)m * SZ_WDN); }
        else if ((r -= 4 * I_DN) < I_AN) { t.W = F_IN(IN_WAIN); t.ldw = 6160; t.ldt = D; nblk = 136; t.kind = 3; t.WT = (bf16*)(ws + WS_WAN); }
        else if ((r -= I_AN) < I_SQ) { t.W = F_IN(IN_WAIN); t.ldw = 6160; t.ldt = D; nblk = 64; t.coff = 2048; t.WT = (bf16*)(ws + WS_WAV); t.tiled = 0; }
        else if ((r -= I_SQ) < I_SQ) { t.W = F_IN(IN_WAOUT); t.ldw = D; t.ldt = D; nblk = 64; t.WT = (bf16*)(ws + WS_WAO); }
        else if ((r -= I_SQ) < I_SQ) { t.W = F_IN(IN_WKV); t.ldw = 2 * D; t.ldt = D; nblk = 64; t.WT = (bf16*)(ws + WS_WK); }
        else if ((r -= I_SQ) < I_SQ) { t.W = F_IN(IN_WKV); t.ldw = 2 * D; t.ldt = D; nblk = 64; t.coff = D; t.WT = (bf16*)(ws + WS_WV); t.tiled = 0; }
        else if ((r -= I_SQ) < I_SQ) { t.W = F_IN(IN_WBQ); t.ldw = D; t.ldt = D; nblk = 64; t.WT = (bf16*)(ws + WS_WQ); }
        else if ((r -= I_SQ) < I_SQ) { t.W = F_IN(IN_WBO); t.ldw = D; t.ldt = D; nblk = 64; t.WT = (bf16*)(ws + WS_WBO); }
        else { r -= I_SQ; const int b = r / I_CV; r -= b * I_CV; t.W = F_IN(IN_CV) + (size_t)b * 512 * D; t.ldw = D; t.ldt = 512; nblk = 64; t.WT = (bf16*)(ws + WS_VTC + (size_t)b * 2048 * 512 * 2); t.tiled = 0; }
#if CV_KPAIR
        if (t.tiled && !CV_TILED_KPAIR) { const int kb = r / nblk; t.k0 = 64 * kb; t.n0 = 32 * (r - kb * nblk); return; }
#if CV_KPAIR == 3
        const int kbn_ = (t.kind == 2) ? 86 : (t.ldt == 512 ? 8 : 32);
        const int w_ = r & 7, R_ = r >> 3, kp_ = R_ % (kbn_ >> 1), nbg_ = R_ / (kbn_ >> 1);
        const int kb = 2 * kp_ + (w_ & 1); t.k0 = 64 * kb; t.n0 = 32 * (4 * nbg_ + (w_ >> 1));
#else
        const int gsh_ = (CV_KPAIR == 2 && t.kind != 2) ? 2 : 1;
        const int q_ = r >> gsh_, kq_ = q_ / nblk; const int kb = (kq_ << gsh_) + (r & ((1 << gsh_) - 1)); t.k0 = 64 * kb; t.n0 = 32 * (q_ - kq_ * nblk);
#endif
#else
        const int kb = r / nblk; t.k0 = 64 * kb; t.n0 = 32 * (r - kb * nblk);
#endif
    };
    TrItem ta, tb; float va[32], vb[32];
    int it = gw;
    if (it < NITEMS) { decode(it, ta); tr_load(ta, va, lane_); }
    while (it < NITEMS) {
        const int i1 = it + NGW, i2 = it + 2 * NGW;
        if (i1 < NITEMS) { decode(i1, tb); tr_load(tb, vb, lane_); }
        tr_store(ta, va, scr, lane_);
        if (i1 >= NITEMS) break;
        if (i2 < NITEMS) { decode(i2, ta); tr_load(ta, va, lane_); }
        tr_store(tb, vb, scr, lane_);
        it = i2;
    }
}
__device__ __forceinline__ void p0_ada(Frame& F) {
    const int tid_ = fresh_tid(), lane_ = tid_ & 63, wave_ = __builtin_amdgcn_readfirstlane(tid_ >> 6); (void)lane_; (void)wave_;
    LAS float* cs = (LAS float*)F.lds;
    LAS float* red = (LAS float*)(F.lds + 73728);
    const int NIT = 256;
    if (F.vcu >= NIT) return;
    for (int i = tid_; i < 9 * D; i += NWAVES * 64) { const int ci = i >> 11, k = i & 2047; const float c = ci == 0 ? F_IN(IN_CP)[k] : F_IN(IN_CS)[(size_t)(ci - 1) * D + k]; cs[i] = silu(c); }
    __syncthreads();
    for (int it = F.vcu; it < NIT; it += F.G) {
        const int mat = it < 115 ? 0 : (it < 230 ? 1 : 2); const int j = it - mat * 115;
        const float* W = mat < 2 ? F_IN(IN_WADA) + (size_t)mat * D * 18432 : F_IN(IN_WADAKV); const int ldw = mat < 2 ? 18432 : 4096;
        const float* bias = mat < 2 ? F_IN(IN_BADA) + (size_t)mat * 18432 : F_IN(IN_BADAKV);
        const int start4 = mat < 2 ? (j < 8 ? 41 * j : 328 + 40 * (j - 8)) : (j < 10 ? 40 * j : 400 + 39 * (j - 10));
        const int n4 = mat < 2 ? (j < 8 ? 41 : 40) : (j < 10 ? 40 : 39);
        const int c0 = 4 * start4, ncol = 4 * n4, ocol = mat * 18432 + c0;
        const bool on = lane_ < n4;
        f32x4 acc[9];
#pragma unroll
        for (int ci = 0; ci < 9; ++ci) acc[ci] = (f32x4){0.f, 0.f, 0.f, 0.f};
#if ADA_ILV
        const float* wp = W + (size_t)wave_ * ldw + c0 + 4 * (on ? lane_ : 0);
#else
        const float* wp = W + (size_t)(wave_ * 256) * ldw + c0 + 4 * (on ? lane_ : 0);
#endif
#if ADA_DB
#define ADA_LOAD(R, kb_) do { _Pragma("unroll") for (int k = 0; k < ADA_DBN; ++k) R[k] = *(const f32x4*)(wp + (size_t)((kb_) + k) * (ADA_ILV ? 8 : 1) * ldw); } while (0)
#define ADA_ACC(R, kb_) do { _Pragma("unroll") for (int k = 0; k < ADA_DBN; ++k) { _Pragma("unroll") for (int ci = 0; ci < 9; ++ci) { const float c = cs[ci * D + (ADA_ILV ? 8 * ((kb_) + k) + wave_ : wave_ * 256 + (kb_) + k)]; acc[ci] += R[k] * c; } \
            asm volatile("" ::: "memory"); } } while (0)
        f32x4 wa[ADA_DBN], wb[ADA_DBN];
        ADA_LOAD(wa, 0);
#pragma unroll 1
        for (int kb = 0; kb < 256; kb += 2 * ADA_DBN) {
            ADA_LOAD(wb, kb + ADA_DBN);
            ADA_ACC(wa, kb);
            ADA_LOAD(wa, kb + 2 * ADA_DBN < 256 ? kb + 2 * ADA_DBN : 256 - ADA_DBN);
            ADA_ACC(wb, kb + ADA_DBN);
        }
#undef ADA_LOAD
#undef ADA_ACC
#else
#pragma unroll 1
        for (int kb = 0; kb < 256; kb += ADA_UNR) {
            f32x4 wv[ADA_UNR];
#pragma unroll
            for (int k = 0; k < ADA_UNR; ++k) wv[k] = *(const f32x4*)(wp + (size_t)(kb + k) * (ADA_ILV ? 8 : 1) * ldw);
#pragma unroll
            for (int k = 0; k < ADA_UNR; ++k) {
#pragma unroll
                for (int ci = 0; ci < 9; ++ci) { const float c = cs[ci * D + (ADA_ILV ? 8 * (kb + k) + wave_ : wave_ * 256 + kb + k)]; acc[ci] += wv[k] * c; }
                asm volatile("" ::: "memory");
            }
        }
#endif
        if (on) {
#pragma unroll
            for (int ci = 0; ci < 9; ++ci) *(LAS f32x4*)(red + (wave_ * 9 + ci) * 164 + 4 * lane_) = acc[ci];
        }
        __syncthreads();
        for (int o = tid_; o < 9 * 164; o += NWAVES * 64) { const int ci = o / 164, c = o - ci * 164;
            if (c < ncol) { float s = bias[c0 + c];
#pragma unroll
                for (int w = 0; w < 8; ++w) s += red[(w * 9 + ci) * 164 + c];
                F_ADA[(size_t)ci * ADA_LD + ocol + c] = s; } }
        __syncthreads();
    }
}
constexpr __host__ __device__ int ada_off(int l, int s, int kind) { return l * 18432 + s * 6144 + kind * 2048; }
constexpr int ADA_KV_SHIFT = 36864, ADA_KV_SCALE = 36864 + 2048;
__device__ __forceinline__ void mod0_phase(Frame& F) {
    const int tid_ = fresh_tid(), lane_ = tid_ & 63, wave_ = __builtin_amdgcn_readfirstlane(tid_ >> 6); (void)lane_; (void)wave_;
    const int gw = F.vcu * NWAVES + wave_, NGW = F.G * NWAVES;
    bf16* H = (bf16*)(F_WS + WS_H);
    const int osh = ada_off(0, 0, 0), osc = ada_off(0, 0, 1);
    for (int row = gw; row < MP; row += NGW) {
        v2u* hr = (v2u*)(H + (size_t)row * D) + lane_;
        if (row >= MR) {
#pragma unroll
            for (int j = 0; j < 8; ++j) hr[64 * j] = (v2u){0u, 0u};
            continue;
        }
        const int ci = row < TP ? 0 : 1 + ((row - TP) >> 4);
        const float* xr = row < TP ? F_IN(IN_XP) + (size_t)row * D : F_IN(IN_XS) + (size_t)(row - TP) * D;
        const f32x4* x4 = (const f32x4*)xr + lane_; const f32x4* sh4 = (const f32x4*)(F_ADA + (size_t)ci * ADA_LD + osh) + lane_; const f32x4* sc4 = (const f32x4*)(F_ADA + (size_t)ci * ADA_LD + osc) + lane_;
#pragma unroll
        for (int j = 0; j < 8; ++j) { const f32x4 x = x4[64 * j], sh = sh4[64 * j], sc = sc4[64 * j]; const f32x4 h = x * (sc + 1.0f) + sh;
            hr[64 * j] = (v2u){pk2(h.x, h.y), pk2(h.z, h.w)}; }
    }
}
template <int SUB>
__device__ __forceinline__ void ln_phase(Frame& F, int osh1, int osc1, bf16* H1, int osh2, int osc2, bf16* H2o, int goff, float gs, int npcs) {
    const int tid_ = fresh_tid(), lane_ = tid_ & 63, wave_ = __builtin_amdgcn_readfirstlane(tid_ >> 6); (void)lane_; (void)wave_;
    const int gw = F.vcu * NWAVES + wave_, NGW = F.G * NWAVES;
    constexpr bool LAST = SUB == 5;
    const float* g = F_IN(IN_LNG) + SUB * D; const float* b = F_IN(IN_LNB) + SUB * D;
    auto finish = [&](int row, int ci, f32x4 (&v)[8], float* xo, bool stat) {
        float s = 0.f;
#pragma unroll
        for (int j = 0; j < 8; ++j) s += (v[j].x + v[j].y) + (v[j].z + v[j].w);
        const float mean = wave_sum(s) * (1.0f / D); float s2 = 0.f;
#pragma unroll
        for (int j = 0; j < 8; ++j) { v[j] = v[j] - mean; s2 += (v[j].x * v[j].x + v[j].y * v[j].y) + (v[j].z * v[j].z + v[j].w * v[j].w); }
        const float rstd = 1.0f / sqrtf(wave_sum(s2) * (1.0f / D) + LN_EPS);
        if (stat && lane_ == 0) *(f32x2v*)((float*)(F_WS + WS_STAT) + 2 * (size_t)row) = (f32x2v){mean, rstd};
#pragma unroll
        for (int j = 0; j < 4; ++j) { const int c = 8 * lane_ + 512 * j;
            v[2 * j] = v[2 * j] * rstd * *(const f32x4*)(g + c) + *(const f32x4*)(b + c); v[2 * j + 1] = v[2 * j + 1] * rstd * *(const f32x4*)(g + c + 4) + *(const f32x4*)(b + c + 4);
            if (xo) { *(f32x4*)(xo + c) = v[2 * j]; *(f32x4*)(xo + c + 4) = v[2 * j + 1]; } }
        const float* ar = F_ADA + (size_t)ci * ADA_LD;
        if (H1) {
#pragma unroll
            for (int j = 0; j < 4; ++j) { const int c = 8 * lane_ + 512 * j;
                const f32x4 h0 = v[2 * j] * (*(const f32x4*)(ar + osc1 + c) + 1.0f) + *(const f32x4*)(ar + osh1 + c), h1 = v[2 * j + 1] * (*(const f32x4*)(ar + osc1 + c + 4) + 1.0f) + *(const f32x4*)(ar + osh1 + c + 4);
                st16_wt(H1 + (size_t)row * D + c, (v4u){pk2(h0.x, h0.y), pk2(h0.z, h0.w), pk2(h1.x, h1.y), pk2(h1.z, h1.w)}); } }
        if (H2o) {
#pragma unroll
            for (int j = 0; j < 4; ++j) { const int c = 8 * lane_ + 512 * j;
                const f32x4 h0 = v[2 * j] * (*(const f32x4*)(ar + osc2 + c) + 1.0f) + *(const f32x4*)(ar + osh2 + c), h1 = v[2 * j + 1] * (*(const f32x4*)(ar + osc2 + c + 4) + 1.0f) + *(const f32x4*)(ar + osh2 + c + 4);
                st16_wt(H2o + (size_t)row * D + c, (v4u){pk2(h0.x, h0.y), pk2(h0.z, h0.w), pk2(h1.x, h1.y), pk2(h1.z, h1.w)}); } }
    };
    f32x4 t[21], xv = {0.f, 0.f, 0.f, 0.f}, gv = {0.f, 0.f, 0.f, 0.f};
#pragma unroll
    for (int pc = 0; pc < 21; ++pc) t[pc] = (f32x4){0.f, 0.f, 0.f, 0.f};
    if (LN_SPRE && F.vcu < 128) {
        const int r = F.vcu, c0 = 256 * wave_ + 4 * lane_;
        const float* zp = (const float*)(F_WS + WS_ZSP) + (size_t)r * D + c0;
#pragma unroll
        for (int pc = 0; pc < 21; ++pc) if (pc < npcs) t[pc] = *(const f32x4*)(zp + (size_t)pc * 128 * D);
        xv = *(const f32x4*)((SUB == 0 ? F_IN(IN_XS) + (size_t)r * D : (const float*)(F_WS + WS_XS) + (size_t)r * D) + c0);
        gv = *(const f32x4*)(F_ADA + (size_t)(1 + (r >> 4)) * ADA_LD + goff + c0);
    }
    {
        const bf16* Zb = (const bf16*)(F_WS + ((SUB & 1) ? WS_ZB1 : WS_ZB0));
        v4u nx[4];
        if (gw < TP) {
#pragma unroll
            for (int j = 0; j < 4; ++j) nx[j] = *(const v4u*)(Zb + (size_t)gw * D + 8 * lane_ + 512 * j); }
        for (int row = gw; row < TP; row += NGW) {
            f32x4 v[8];
#pragma unroll
            for (int j = 0; j < 4; ++j) { const v4u w = nx[j];
                v[2 * j] = (f32x4){__uint_as_float(w.x << 16), __uint_as_float(w.x & 0xffff0000u), __uint_as_float(w.y << 16), __uint_as_float(w.y & 0xffff0000u)};
                v[2 * j + 1] = (f32x4){__uint_as_float(w.z << 16), __uint_as_float(w.z & 0xffff0000u), __uint_as_float(w.w << 16), __uint_as_float(w.w & 0xffff0000u)}; }
            if (row + NGW < TP) {
#pragma unroll
                for (int j = 0; j < 4; ++j) nx[j] = *(const v4u*)(Zb + (size_t)(row + NGW) * D + 8 * lane_ + 512 * j); }
            finish(row, 0, v, LAST ? F_OUT + O_YP + (size_t)row * D : nullptr, !LAST);
        }
    }
    for (int rr = F.vcu; rr < 256; rr += F.G) {
    for (int srep_ = 0; srep_ < LN_SREP; ++srep_) {
    asm volatile("" ::: "memory");
    __syncthreads();
    if (rr < 128) {
        LAS float* red = (LAS float*)F.lds;
        const int r = rr, row = TP + r, ci = 1 + (r >> 4), c0 = 256 * wave_ + 4 * lane_;
        const float* zp = (const float*)(F_WS + WS_ZSP) + (size_t)r * D + c0;
        float* xs = (float*)(F_WS + WS_XS) + (size_t)r * D;
        const float* ar = F_ADA + (size_t)ci * ADA_LD;
        if (!(LN_SPRE && rr == F.vcu && srep_ == 0)) {
#pragma unroll
            for (int pc = 0; pc < 21; ++pc) if (pc < npcs) t[pc] = *(const f32x4*)(zp + (size_t)pc * 128 * D);
            xv = *(const f32x4*)((SUB == 0 ? F_IN(IN_XS) + (size_t)r * D : (const float*)xs) + c0);
            gv = *(const f32x4*)(ar + goff + c0);
        }
        f32x4 v = t[0];
#pragma unroll
        for (int pc = 1; pc < 21; ++pc) if (pc < npcs) v += t[pc];
        v = xv * 1.41421356237309515f + (gv + 1.0f) * (v * gs);
        const float s = wave_sum((v.x + v.y) + (v.z + v.w));
        if (lane_ == 0) red[wave_] = s;
        __syncthreads();
        float tot = 0.f;
#pragma unroll
        for (int w = 0; w < 8; ++w) tot += red[w];
        const float mean = tot * (1.0f / D);
        v = v - mean;
        const float s2 = wave_sum((v.x * v.x + v.y * v.y) + (v.z * v.z + v.w * v.w));
        if (lane_ == 0) red[8 + wave_] = s2;
        __syncthreads();
        float tot2 = 0.f;
#pragma unroll
        for (int w = 0; w < 8; ++w) tot2 += red[8 + w];
        const float rstd = 1.0f / sqrtf(tot2 * (1.0f / D) + LN_EPS);
        v = v * rstd * *(const f32x4*)(g + c0) + *(const f32x4*)(b + c0);
        if (srep_ == LN_SREP - 1) *(f32x4*)((LAST ? F_OUT + O_YS + (size_t)r * D : xs) + c0) = v;
        if (H1) { const f32x4 h = v * (*(const f32x4*)(ar + osc1 + c0) + 1.0f) + *(const f32x4*)(ar + osh1 + c0); *(v2u*)(H1 + (size_t)row * D + c0) = (v2u){pk2(h.x, h.y), pk2(h.z, h.w)}; }
        if (H2o) { const f32x4 h = v * (*(const f32x4*)(ar + osc2 + c0) + 1.0f) + *(const f32x4*)(ar + osh2 + c0); *(v2u*)(H2o + (size_t)row * D + c0) = (v2u){pk2(h.x, h.y), pk2(h.z, h.w)}; }
    } else {
        const int row = MR + (rr - 128), c0 = 256 * wave_ + 4 * lane_;
        if (H1) *(v2u*)(H1 + (size_t)row * D + c0) = (v2u){0u, 0u};
        if (H2o) *(v2u*)(H2o + (size_t)row * D + c0) = (v2u){0u, 0u};
    }
    }
    }
}
__device__ __forceinline__ float logsigmoid_f(float x) { return fminf(x, 0.f) - __logf(1.0f + __expf(-fabsf(x))); }
__device__ __forceinline__ void gla_g2_phase(Frame& F, int u0, int u1, int ustart, int ustep) {
    const int tid_ = fresh_tid(), lane_ = tid_ & 63, wave_ = __builtin_amdgcn_readfirstlane(tid_ >> 6); (void)lane_; (void)wave_;
    constexpr int LDQ = 264;
    LAS bf16* QTs = (LAS bf16*)F.lds; LAS bf16* KTs = (LAS bf16*)(F.lds + 64 * LDQ * 2); LAS float* GL = (LAS float*)(F.lds + 2 * 64 * LDQ * 2);
    LAS float* BBs = (LAS float*)(F.lds + 2 * 64 * LDQ * 2 + 4096);
    LAS float* HS = (LAS float*)(F.lds + 2 * 64 * LDQ * 2 + 4096 + 65536);
    static_assert(2 * 64 * LDQ * 2 + 4096 + 65536 + 2048 <= LDSCTL_OFF, "G2 LDS");
    const bf16* Qg = (const bf16*)(F_WS + WS_QG); const bf16* Kg = (const bf16*)(F_WS + WS_KG); const float* GKL = (const float*)(F_WS + WS_GKL);
    bf16* QT = (bf16*)(F_WS + WS_QT); bf16* KDT = (bf16*)(F_WS + WS_KDT); bf16* P = (bf16*)(F_WS + WS_P); float* DEC = (float*)(F_WS + WS_DEC);
    const int fr = lane_ & 15, fq = lane_ >> 4;
    for (int unit = u0 + ustart; unit < u1; unit += ustep) {
        const int ch = unit >> 2, h = unit & 3;
        const int nrows = ch < 256 ? 64 : 16, row0 = ch < 256 ? ch * 64 : TP + (ch - 256) * 16;
#pragma unroll
        for (int i = 0; i < 4; ++i) { const int idx = tid_ + 512 * i, j = idx >> 5, seg = idx & 31; v4u qv = {0u, 0u, 0u, 0u}, kv = {0u, 0u, 0u, 0u};
            if (j < nrows) { qv = *(const v4u*)(Qg + (size_t)(row0 + j) * 1024 + h * 256 + seg * 8); kv = *(const v4u*)(Kg + (size_t)(row0 + j) * 1024 + h * 256 + seg * 8); }
            *(LAS v4u*)(QTs + j * LDQ + seg * 8) = qv; *(LAS v4u*)(KTs + j * LDQ + seg * 8) = kv; }
        if (tid_ < 256) { const int j = tid_ >> 2, q4 = tid_ & 3; f32x4 v = {0.f, 0.f, 0.f, 0.f}; if (j < nrows) v = *(const f32x4*)(GKL + (size_t)(row0 + j) * 16 + 4 * q4); *(LAS f32x4*)(GL + j * 16 + 4 * q4) = v; }
        __syncthreads();
        const int c = tid_ & 255, jh = tid_ >> 8, col = h * 256 + c, j0 = 32 * jh;
        {
            float w2[16];
#pragma unroll
            for (int r = 0; r < 16; ++r) w2[r] = F_IN(IN_WGK2)[r * 1024 + col];
            const float bias = F_IN(IN_BGK)[col];
            float sum = 0.f;
#pragma unroll 4
            for (int jj = 0; jj < 32; ++jj) { const int j = j0 + jj; float la = 0.f;
                if (j < nrows) { float x = bias;
#pragma unroll
                    for (int r4 = 0; r4 < 4; ++r4) { const f32x4 g = *(const LAS f32x4*)(GL + j * 16 + 4 * r4); x += g.x * w2[4 * r4] + g.y * w2[4 * r4 + 1] + g.z * w2[4 * r4 + 2] + g.w * w2[4 * r4 + 3]; }
                    la = logsigmoid_f(x) * 0.0625f; }
                BBs[j * 256 + c] = la; sum += la; }
            HS[jh * 256 + c] = sum;
        }
        __syncthreads();
        {
            const float h0 = HS[c], blast = h0 + HS[256 + c];
            float b = jh ? h0 : 0.f;
            bf16* qt_g = QT + ((size_t)unit * 64 + j0) * 256 + c;
            bf16* kd_g = KDT + ((size_t)unit * 256 + c) * 64 + j0;
            if (jh == 0) DEC[(size_t)unit * 256 + c] = __expf(blast);
#pragma unroll 1
            for (int j8 = 0; j8 < 4; ++j8) {
                float kd[8];
                if (j0 + j8 * 8 < nrows) {
#pragma unroll
                for (int e = 0; e < 8; ++e) { const int j = j0 + j8 * 8 + e;
                    b += BBs[j * 256 + c];
                    const float qv = bf2f(QTs[j * LDQ + c]), kv = bf2f(KTs[j * LDQ + c]);
                    const unsigned short qb = (unsigned short)f2bf(qv * __expf(b)), kb = (unsigned short)f2bf(kv * __expf(-b));
                    QTs[j * LDQ + c] = qb; KTs[j * LDQ + c] = kb; qt_g[(size_t)(j8 * 8 + e) * 256] = qb;
                    kd[e] = kv * __expf(blast - b); }
                } else {
#pragma unroll
                for (int e = 0; e < 8; ++e) { qt_g[(size_t)(j8 * 8 + e) * 256] = 0; kd[e] = 0.f; }
                }
                v4u o; o.x = pk2(kd[0], kd[1]); o.y = pk2(kd[2], kd[3]); o.z = pk2(kd[4], kd[5]); o.w = pk2(kd[6], kd[7]);
                *(v4u*)(kd_g + j8 * 8) = o;
            }
        }
        __syncthreads();
        {
            const int mi = wave_ & 3, nb = 2 * (wave_ >> 2);
            f32x4 acc0 = {0.f, 0.f, 0.f, 0.f}, acc1 = {0.f, 0.f, 0.f, 0.f};
#pragma unroll
            for (int s = 0; s < 8; ++s) {
                const bf16x8 a = *(const LAS bf16x8*)(QTs + (mi * 16 + fr) * LDQ + s * 32 + fq * 8);
                const bf16x8 b0 = *(const LAS bf16x8*)(KTs + (nb * 16 + fr) * LDQ + s * 32 + fq * 8);
                const bf16x8 b1 = *(const LAS bf16x8*)(KTs + (nb * 16 + 16 + fr) * LDQ + s * 32 + fq * 8);
                acc0 = MFMA16(b0, a, acc0); acc1 = MFMA16(b1, a, acc1);
            }
            const int i = mi * 16 + fr; bf16* pr = P + ((size_t)unit * 64 + i) * 64;
#pragma unroll
            for (int t = 0; t < 2; ++t) { const f32x4 a = t ? acc1 : acc0; const int jc = (nb + t) * 16 + 4 * fq;
                const float p0 = jc + 0 <= i ? a[0] : 0.f, p1 = jc + 1 <= i ? a[1] : 0.f, p2 = jc + 2 <= i ? a[2] : 0.f, p3 = jc + 3 <= i ? a[3] : 0.f;
                *(v2u*)(pr + jc) = (v2u){pk2(p0, p1), pk2(p2, p3)}; }
        }
        __syncthreads();
    }
}
constexpr size_t WS_SL = WS_UT, WS_GD = WS_SL + (size_t)16 * 4 * 256 * 512 * 4, WS_OB = WS_GD + (size_t)16 * 4 * 256 * 4;
static_assert(WS_OB + SZ_B16ACT <= WS_GLA_END && WS_GD % 256 == 0 && WS_OB % 256 == 0, "GLA recurrence workspace");
constexpr int GL_KDP = 144, GL_QTP = 528, GL_PP = 144;
constexpr int GL_KD = 0, GL_QT = GL_KD + 256 * GL_KDP, GL_P = GL_QT + 64 * GL_QTP, GL_DEC = GL_P + 64 * GL_PP, GL_END = GL_DEC + 1024;
static_assert(GL_END <= LDSCTL_OFF, "GLA LDS");
template <bool WITH_O>
__device__ __forceinline__ void gla_unit(Frame& F, f32x4 (&S)[16], int ch0, int nc, int h, int slice, int tok0, int tokstep, int nrows_o, int tid_, int wave_, int fr, int fq) {
    const bf16* VT = (const bf16*)(F_WS + WS_VTG); const bf16* KDT = (const bf16*)(F_WS + WS_KDT); const bf16* QT = (const bf16*)(F_WS + WS_QT); const bf16* P = (const bf16*)(F_WS + WS_P);
    const float* DEC = (const float*)(F_WS + WS_DEC); bf16* OB = (bf16*)(F_WS + WS_OB);
    LAS unsigned char* KDs = F.lds + GL_KD; LAS unsigned char* QTs = F.lds + GL_QT; LAS unsigned char* Ps = F.lds + GL_P; LAS float* DECs = (LAS float*)(F.lds + GL_DEC);
    const int vc = slice * 128 + wave_ * 16 + fr;
#if VT_BLOCKED
    const int tka_ = tok0 + 8 * fq, tkb_ = tka_ + 32;
    const bf16* vtp = VT + ((size_t)(tka_ >> 6) * 2048 + h * 512 + vc) * 64 + (tka_ & 63);
    const bf16* vtq = VT + ((size_t)(tkb_ >> 6) * 2048 + h * 512 + vc) * 64 + (tkb_ & 63);
#else
    const bf16* vtp = VT + (size_t)(h * 512 + vc) * MP + tok0 + 8 * fq;
#endif
    v4u rk[4], rq[4], rp; f32x4 rd;
#define GL_LOAD(ch) do { const size_t u_ = (size_t)(ch) * 4 + h; \
        _Pragma("unroll") for (int i_ = 0; i_ < 4; ++i_) { const int idx_ = tid_ + 512 * i_; rk[i_] = *(const v4u*)(KDT + (u_ * 256 + (idx_ >> 3)) * 64 + (idx_ & 7) * 8); } \
        if (WITH_O) { _Pragma("unroll") for (int i_ = 0; i_ < 4; ++i_) { const int idx_ = tid_ + 512 * i_; rq[i_] = *(const v4u*)(QT + (u_ * 64 + (idx_ >> 5)) * 256 + (idx_ & 31) * 8); } \
                      rp = *(const v4u*)(P + (u_ * 64 + (tid_ >> 3)) * 64 + (tid_ & 7) * 8); } \
        if (tid_ < 64) rd = *(const f32x4*)(DEC + u_ * 256 + 4 * tid_); } while (0)
#define GL_STORE() do { \
        _Pragma("unroll") for (int i_ = 0; i_ < 4; ++i_) { const int idx_ = tid_ + 512 * i_; *(LAS v4u*)(KDs + (idx_ >> 3) * GL_KDP + (idx_ & 7) * 16) = rk[i_]; } \
        if (WITH_O) { _Pragma("unroll") for (int i_ = 0; i_ < 4; ++i_) { const int idx_ = tid_ + 512 * i_; *(LAS v4u*)(QTs + (idx_ >> 5) * GL_QTP + (idx_ & 31) * 16) = rq[i_]; } \
                      *(LAS v4u*)(Ps + (tid_ >> 3) * GL_PP + (tid_ & 7) * 16) = rp; } \
        if (tid_ < 64) *(LAS f32x4*)(DECs + 4 * tid_) = rd; } while (0)
    GL_LOAD(ch0);
    for (int c = 0; c < nc; ++c) {
        GL_STORE();
        __syncthreads();
        if (c + 1 < nc) GL_LOAD(ch0 + c + 1);
#if VT_BLOCKED
        const bf16x8 vb0 = *(const bf16x8*)(vtp + (size_t)c * (tokstep >> 6) * 2048 * 64), vb1 = *(const bf16x8*)(vtq + (size_t)c * (tokstep >> 6) * 2048 * 64);
#else
        const bf16* vt = vtp + (size_t)c * tokstep;
        const bf16x8 vb0 = *(const bf16x8*)vt, vb1 = *(const bf16x8*)(vt + 32);
#endif
        if (WITH_O) {
            f32x4 o[4];
#pragma unroll
            for (int m2 = 0; m2 < 4; ++m2) o[m2] = (f32x4){0.f, 0.f, 0.f, 0.f};
#pragma unroll
            for (int ks = 0; ks < 8; ++ks) {
                const v4u sw = {pk2(S[2 * ks][0], S[2 * ks][1]), pk2(S[2 * ks][2], S[2 * ks][3]), pk2(S[2 * ks + 1][0], S[2 * ks + 1][1]), pk2(S[2 * ks + 1][2], S[2 * ks + 1][3])};
                const bf16x8 sb = __builtin_bit_cast(bf16x8, sw);
#pragma unroll
                for (int m2 = 0; m2 < 4; ++m2) {
                    LAS unsigned char* qp = QTs + (16 * m2 + fr) * GL_QTP + ks * 64 + fq * 8;
                    const v2u qlo = *(const LAS v2u*)qp, qhi = *(const LAS v2u*)(qp + 32);
                    const v4u qw = {qlo.x, qlo.y, qhi.x, qhi.y};
                    o[m2] = MFMA16(__builtin_bit_cast(bf16x8, qw), sb, o[m2]);
                }
                __builtin_amdgcn_sched_barrier(0);
            }
#pragma unroll
            for (int m2 = 0; m2 < 4; ++m2) {
                LAS unsigned char* pp = Ps + (16 * m2 + fr) * GL_PP + fq * 16;
                o[m2] = MFMA16(*(const LAS bf16x8*)pp, vb0, o[m2]);
                o[m2] = MFMA16(*(const LAS bf16x8*)(pp + 64), vb1, o[m2]);
            }
            bf16* obu = OB + ((size_t)tok0 + (size_t)c * tokstep) * D + h * 512;
            const unsigned olo = (unsigned)(4 * fq) * D + (unsigned)vc;
#pragma unroll
            for (int m2 = 0; m2 < 4; ++m2)
#pragma unroll
                for (int j = 0; j < 4; ++j) { const int i = 16 * m2 + 4 * fq + j; if (i < nrows_o) (obu + (size_t)(16 * m2 + j) * D)[olo] = (bf16)f2bf(o[m2][j]); }
        }
#pragma unroll
        for (int mi = 0; mi < 16; ++mi) {
            const f32x4 d4 = *(const LAS f32x4*)(DECs + 16 * mi + 4 * fq);
            LAS unsigned char* kp = KDs + (16 * mi + fr) * GL_KDP + fq * 16;
            const bf16x8 a0 = *(const LAS bf16x8*)kp, a1 = *(const LAS bf16x8*)(kp + 64);
            S[mi] = S[mi] * d4;
            S[mi] = MFMA16(a0, vb0, S[mi]);
            S[mi] = MFMA16(a1, vb1, S[mi]);
            if (mi & 1) __builtin_amdgcn_sched_barrier(0);
        }
        __syncthreads();
    }
#undef GL_LOAD
#undef GL_STORE
}
__device__ __forceinline__ void gla_pass1_phase(Frame& F) {
    const int tid_ = fresh_tid(), lane_ = tid_ & 63, wave_ = __builtin_amdgcn_readfirstlane(tid_ >> 6);
    const int fr = lane_ & 15, fq = lane_ >> 4;
    float* SL = (float*)(F_WS + WS_SL); float* GD = (float*)(F_WS + WS_GD); const float* DEC = (const float*)(F_WS + WS_DEC);
    for (int id = F.vcu; id < 15 * 16; id += F.G) {
        const int g = id >> 4, h = (id >> 2) & 3, slice = id & 3;
        f32x4 S[16];
#pragma unroll
        for (int mi = 0; mi < 16; ++mi) S[mi] = (f32x4){0.f, 0.f, 0.f, 0.f};
        gla_unit<false>(F, S, 16 * g, 16, h, slice, 16 * g * 64, 64, 0, tid_, wave_, fr, fq);
        const int vc = slice * 128 + wave_ * 16 + fr;
        float* slu = SL + (size_t)(g * 4 + h) * 256 * 512; const unsigned slo = (unsigned)(4 * fq) * 512 + (unsigned)vc;
#pragma unroll
        for (int mi = 0; mi < 16; ++mi)
#pragma unroll
            for (int j = 0; j < 4; ++j) (slu + (size_t)(16 * mi + j) * 512)[slo] = S[mi][j];
        if (slice == 0 && tid_ < 256) { float gd = 1.0f;
            for (int c = 0; c < 16; ++c) gd *= DEC[(size_t)((16 * g + c) * 4 + h) * 256 + tid_];
            GD[(size_t)(g * 4 + h) * 256 + tid_] = gd; }
    }
    if (G2_SPLIT && F.G > 240 && F.vcu >= 240) gla_g2_phase(F, 1024, NCH * 4, F.vcu - 240, F.G - 240);
}
__device__ __forceinline__ void gla_carry_phase(Frame& F) {
    const int tid_ = fresh_tid();
    float* SL = (float*)(F_WS + WS_SL); const float* GD = (const float*)(F_WS + WS_GD);
    for (int e = blockIdx.x * (NWAVES * 64) + tid_; e < 4 * 256 * 128; e += F.G * NWAVES * 64) {
        const int v4 = e & 127, k = (e >> 7) & 255, h = e >> 15;
        f32x4 S = {0.f, 0.f, 0.f, 0.f};
        f32x4 t[15]; float gd[15];
#pragma unroll
        for (int g = 0; g < 15; ++g) { t[g] = *(const f32x4*)(SL + ((size_t)(g * 4 + h) * 256 + k) * 512 + 4 * v4); gd[g] = GD[(size_t)(g * 4 + h) * 256 + k]; }
#pragma unroll
        for (int g = 0; g < 15; ++g) { *(f32x4*)(SL + ((size_t)(g * 4 + h) * 256 + k) * 512 + 4 * v4) = S; S = S * gd[g] + t[g]; }
        *(f32x4*)(SL + ((size_t)(15 * 4 + h) * 256 + k) * 512 + 4 * v4) = S;
    }
}
__device__ __forceinline__ void gla_pass2_phase(Frame& F, bool with_sample = true) {
    const int tid_ = fresh_tid(), lane_ = tid_ & 63, wave_ = __builtin_amdgcn_readfirstlane(tid_ >> 6);
    const int fr = lane_ & 15, fq = lane_ >> 4;
    const float* SL = (const float*)(F_WS + WS_SL);
    for (int id = F.vcu; with_sample && id < 128; id += F.G) {
        const int b = id >> 4, h = (id >> 2) & 3, slice = id & 3; const int vc = slice * 128 + wave_ * 16 + fr;
        const float* s0 = F_IN(IN_STATE) + ((size_t)(b * 4 + h) * 256) * 512; float* s1 = F_OUT + O_SS + ((size_t)(b * 4 + h) * 256) * 512;
        const unsigned slo = (unsigned)(4 * fq) * 512 + (unsigned)vc;
        f32x4 S[16];
#pragma unroll
        for (int mi = 0; mi < 16; ++mi)
#pragma unroll
            for (int j = 0; j < 4; ++j) S[mi][j] = (s0 + (size_t)(16 * mi + j) * 512)[slo];
        gla_unit<true>(F, S, 256 + b, 1, h, slice, TP + 16 * b, 64, 16, tid_, wave_, fr, fq);
#pragma unroll
        for (int mi = 0; mi < 16; ++mi)
#pragma unroll
            for (int j = 0; j < 4; ++j) (s1 + (size_t)(16 * mi + j) * 512)[slo] = S[mi][j];
    }
    for (int id = F.vcu; id < 256; id += F.G) {
        const int g = id >> 4, h = (id >> 2) & 3, slice = id & 3; const int vc = slice * 128 + wave_ * 16 + fr;
        const float* s0 = SL + ((size_t)(g * 4 + h) * 256) * 512; const unsigned slo = (unsigned)(4 * fq) * 512 + (unsigned)vc;
        f32x4 S[16];
#pragma unroll
        for (int mi = 0; mi < 16; ++mi)
#pragma unroll
            for (int j = 0; j < 4; ++j) S[mi][j] = (s0 + (size_t)(16 * mi + j) * 512)[slo];
        gla_unit<true>(F, S, 16 * g, 16, h, slice, 16 * g * 64, 64, 64, tid_, wave_, fr, fq);
        if (g == 15) { float* s1 = F_OUT + O_SP + ((size_t)h * 256) * 512;
#pragma unroll
            for (int mi = 0; mi < 16; ++mi)
#pragma unroll
                for (int j = 0; j < 4; ++j) (s1 + (size_t)(16 * mi + j) * 512)[slo] = S[mi][j]; }
    }
}
__device__ __forceinline__ void gla_gn_phase(Frame& F, bf16* OG) {
    const int tid_ = fresh_tid(), lane_ = tid_ & 63, wave_ = __builtin_amdgcn_readfirstlane(tid_ >> 6);
    const int gw = F.vcu * NWAVES + wave_, NGW = F.G * NWAVES;
    const bf16* OB = (const bf16*)(F_WS + WS_OB); const bf16* Gg = (const bf16*)(F_WS + WS_GG);
    const f32x4 gn0 = *(const f32x4*)(F_IN(IN_GNORM) + 8 * lane_), gn1 = *(const f32x4*)(F_IN(IN_GNORM) + 8 * lane_ + 4);
    v4u ovn = {0u, 0u, 0u, 0u}, gvn = {0u, 0u, 0u, 0u};
    if (gw < MR * 4) { const size_t off = (size_t)(gw >> 2) * D + (gw & 3) * 512 + 8 * lane_; ovn = *(const v4u*)(OB + off); gvn = *(const v4u*)(Gg + off); }
    for (int t = gw; t < MR * 4; t += NGW) {
        const int row = t >> 2, h = t & 3; const size_t off = (size_t)row * D + h * 512 + 8 * lane_;
        const v4u ov = ovn, gv = gvn;
        if (t + NGW < MR * 4) { const int t2 = t + NGW; const size_t off2 = (size_t)(t2 >> 2) * D + (t2 & 3) * 512 + 8 * lane_; ovn = *(const v4u*)(OB + off2); gvn = *(const v4u*)(Gg + off2); }
        float o[8], g[8];
#pragma unroll
        for (int i = 0; i < 4; ++i) { const unsigned ow = i == 0 ? ov.x : i == 1 ? ov.y : i == 2 ? ov.z : ov.w, gw2 = i == 0 ? gv.x : i == 1 ? gv.y : i == 2 ? gv.z : gv.w;
            o[2 * i] = bf2f((unsigned short)(ow & 0xffff)); o[2 * i + 1] = bf2f((unsigned short)(ow >> 16)); g[2 * i] = bf2f((unsigned short)(gw2 & 0xffff)); g[2 * i + 1] = bf2f((unsigned short)(gw2 >> 16)); }
        float ss = 0.f;
#pragma unroll
        for (int i = 0; i < 8; ++i) ss += o[i] * o[i];
        const float rinv = 1.0f / sqrtf(wave_sum(ss) * (1.0f / 512.0f) + RMS_EPS);
        float r[8];
#pragma unroll
        for (int i = 0; i < 8; ++i) r[i] = o[i] * rinv * (i < 4 ? gn0[i & 3] : gn1[i & 3]) * silu(g[i]);
        *(v4u*)(OG + off) = (v4u){pk2(r[0], r[1]), pk2(r[2], r[3]), pk2(r[4], r[5]), pk2(r[6], r[7])};
    }
}
struct AttnState { f32x4 o[8]; float m, l; };
template <class TabP, class VLoad>
__device__ __forceinline__ void attn_block(AttnState& st, const bf16x8 (&qf)[4], const bf16x8 (&kf)[2][4], TabP tab, int qpos, int kpos0, int nvalid_tiles, int fq, const VLoad& vload) {
    f32x4 s0 = {0.f, 0.f, 0.f, 0.f}, s1 = {0.f, 0.f, 0.f, 0.f};
#pragma unroll
    for (int s = 0; s < 4; ++s) { s0 = MFMA16(kf[0][s], qf[s], s0); s1 = MFMA16(kf[1][s], qf[s], s1); }
    const float scale = 0.08838834764831845f * 1.4426950408889634f;
    float sv[8]; float mx = -1e30f;
#pragma unroll
    for (int j = 0; j < 4; ++j) {
        int d0 = qpos - (kpos0 + 4 * fq + j); d0 = d0 < -256 ? -256 : (d0 > 256 ? 256 : d0);
        int d1 = qpos - (kpos0 + 16 + 4 * fq + j); d1 = d1 < -256 ? -256 : (d1 > 256 ? 256 : d1);
        sv[j] = s0[j] * scale + tab[d0 + 256];
        sv[4 + j] = nvalid_tiles > 1 ? s1[j] * scale + tab[d1 + 256] : -1e30f;
        mx = fmaxf(mx, fmaxf(sv[j], sv[4 + j]));
    }
    mx = rows_max(mx);
    const float mnew = fmaxf(st.m, mx), alpha = __builtin_amdgcn_exp2f(st.m - mnew);
    float p[8]; float rs = 0.f;
#pragma unroll
    for (int j = 0; j < 8; ++j) { p[j] = __builtin_amdgcn_exp2f(sv[j] - mnew); rs += p[j]; }
    st.l = st.l * alpha + rs;
    const bool grow = __builtin_amdgcn_ballot_w64(mnew > st.m) != 0ull;
    st.m = mnew;
    v4u pw; pw.x = pk2(p[0], p[1]); pw.y = pk2(p[2], p[3]); pw.z = pk2(p[4], p[5]); pw.w = pk2(p[6], p[7]);
    const bf16x8 pf = __builtin_bit_cast(bf16x8, pw);
#pragma unroll
    for (int dt = 0; dt < 8; ++dt) {
        const v2u lo = vload(dt, 0), hi = vload(dt, 1);
        const v4u vw = {lo.x, lo.y, hi.x, hi.y};
        if (grow) st.o[dt] = st.o[dt] * alpha;
        st.o[dt] = MFMA16(__builtin_bit_cast(bf16x8, vw), pf, st.o[dt]);
    }
}
__device__ __forceinline__ bf16x8 cvt8(const float* p) {
    const f32x4 a = *(const f32x4*)p, b = *(const f32x4*)(p + 4);
    const v4u w = {pk2(a.x, a.y), pk2(a.z, a.w), pk2(b.x, b.y), pk2(b.z, b.w)};
    return __builtin_bit_cast(bf16x8, w);
}
#ifndef AT_VPRE
#define AT_VPRE 2
#endif
#ifndef AT_RESCALE_ALWAYS
#define AT_RESCALE_ALWAYS 0
#endif
#ifndef AT_MODE2
#define AT_MODE2 1
#endif
#ifndef AT_SKEW
#define AT_SKEW 0
#endif
#ifndef AT_AHEAD2
#define AT_AHEAD2 0
#endif
#ifndef AT_BALANCE
#define AT_BALANCE 1
#endif
#ifndef AT_STAGGER
#define AT_STAGGER 0
#endif
constexpr int AT_KROW = 272, AT_VROW = 136;
constexpr int AT_KT = 0, AT_VT = 2 * 64 * AT_KROW, AT_TAB = AT_VT + (AT_SKEW ? 3 : 2) * 128 * AT_VROW, AT_END = AT_TAB + 16 * 516 * 4;
static_assert(AT_END <= LDSCTL_OFF, "attention LDS");
constexpr int AT_OS = 0, AT_ML = 65536;
template <int MODE>
__device__ __forceinline__ void attn_block64(AttnState& st, const bf16x8 (&qf)[4], const LAS unsigned char* kt, const LAS unsigned char* vt, const LAS float* tab, int qpos, int kpos0, int fr, int fq) {
    f32x4 sc[4];
#pragma unroll
    for (int t = 0; t < 4; ++t) { sc[t] = (f32x4){0.f, 0.f, 0.f, 0.f};
#pragma unroll
        for (int s = 0; s < 4; ++s) sc[t] = MFMA16(*(const LAS bf16x8*)(kt + (16 * t + fr) * AT_KROW + s * 64 + fq * 16), qf[s], sc[t]); }
    const LAS unsigned char* vp = vt + fr * AT_VROW + fq * 8;
    v2u vf[AT_VPRE ? AT_VPRE : 1][4];
#if AT_VPRE
#pragma unroll
    for (int dt = 0; dt < AT_VPRE; ++dt)
#pragma unroll
        for (int q = 0; q < 4; ++q) vf[dt][q] = *(const LAS v2u*)(vp + dt * 16 * AT_VROW + q * 32);
#endif
    const float scale = 0.08838834764831845f * 1.4426950408889634f;
    float sv[16]; float mx = -1e30f;
    const float ub = tab[512];
    const LAS float* tabn = tab + (qpos - kpos0 - 4 * fq + 256 - 63);
#pragma unroll
    for (int t = 0; t < 4; ++t)
#pragma unroll
        for (int j = 0; j < 4; ++j) {
            float bias = ub;
            if (MODE == 0) { int d0 = qpos - (kpos0 + 16 * t + 4 * fq + j); d0 = d0 < -256 ? -256 : (d0 > 256 ? 256 : d0); bias = tab[d0 + 256]; }
            if (MODE == 2) bias = tabn[63 - 16 * t - j];
            sv[4 * t + j] = sc[t][j] * scale + bias; mx = fmaxf(mx, sv[4 * t + j]); }
    mx = rows_max(mx);
    const float mnew = fmaxf(st.m, mx), alpha = __builtin_amdgcn_exp2f(st.m - mnew);
    float p[16]; float rs = 0.f;
#pragma unroll
    for (int j = 0; j < 16; ++j) { p[j] = __builtin_amdgcn_exp2f(sv[j] - mnew); rs += p[j]; }
    st.l = st.l * alpha + rs;
    const bool grow = __builtin_amdgcn_ballot_w64(mnew > st.m) != 0ull;
    st.m = mnew;
    const v4u pw0 = {pk2(p[0], p[1]), pk2(p[2], p[3]), pk2(p[4], p[5]), pk2(p[6], p[7])}, pw1 = {pk2(p[8], p[9]), pk2(p[10], p[11]), pk2(p[12], p[13]), pk2(p[14], p[15])};
    const bf16x8 pf0 = __builtin_bit_cast(bf16x8, pw0), pf1 = __builtin_bit_cast(bf16x8, pw1);
#if AT_RESCALE_ALWAYS
    (void)grow;
#pragma unroll
    for (int dt = 0; dt < 8; ++dt) st.o[dt] = st.o[dt] * alpha;
#else
    if (grow) {
        asm volatile("" ::: "memory");
#pragma unroll
        for (int dt = 0; dt < 8; ++dt) st.o[dt] = st.o[dt] * alpha;
    }
#endif
#pragma unroll
    for (int dt = 0; dt < 8; ++dt) {
#if AT_VPRE
        constexpr int NV_ = AT_VPRE; const int sl_ = dt % NV_;
        const v4u v0 = {vf[sl_][0].x, vf[sl_][0].y, vf[sl_][1].x, vf[sl_][1].y}, v1 = {vf[sl_][2].x, vf[sl_][2].y, vf[sl_][3].x, vf[sl_][3].y};
        st.o[dt] = MFMA16(__builtin_bit_cast(bf16x8, v0), pf0, st.o[dt]);
        st.o[dt] = MFMA16(__builtin_bit_cast(bf16x8, v1), pf1, st.o[dt]);
        if (dt + NV_ < 8) {
#pragma unroll
            for (int q = 0; q < 4; ++q) vf[sl_][q] = *(const LAS v2u*)(vp + (dt + NV_) * 16 * AT_VROW + q * 32);
        }
#else
        const LAS unsigned char* vq = vp + dt * 16 * AT_VROW;
        const v2u a0 = *(const LAS v2u*)vq, a1 = *(const LAS v2u*)(vq + 32), b0 = *(const LAS v2u*)(vq + 64), b1 = *(const LAS v2u*)(vq + 96);
        const v4u v0 = {a0.x, a0.y, a1.x, a1.y}, v1 = {b0.x, b0.y, b1.x, b1.y};
        st.o[dt] = MFMA16(__builtin_bit_cast(bf16x8, v0), pf0, st.o[dt]);
        st.o[dt] = MFMA16(__builtin_bit_cast(bf16x8, v1), pf1, st.o[dt]);
#endif
    }
}
struct AttnP { bf16x8 pf0, pf1; float alpha; bool grow; };
template <bool UNIB>
__device__ __forceinline__ void attn_qks(AttnState& st, AttnP& P, const bf16x8 (&qf)[4], const LAS unsigned char* kt, const LAS float* tab, int qpos, int kpos0, int fr, int fq) {
    f32x4 sc[4];
#pragma unroll
    for (int t = 0; t < 4; ++t) { sc[t] = (f32x4){0.f, 0.f, 0.f, 0.f};
#pragma unroll
        for (int s = 0; s < 4; ++s) sc[t] = MFMA16(*(const LAS bf16x8*)(kt + (16 * t + fr) * AT_KROW + s * 64 + fq * 16), qf[s], sc[t]); }
    const float scale = 0.08838834764831845f * 1.4426950408889634f;
    float sv[16]; float mx = -1e30f;
    const float ub = tab[512];
#pragma unroll
    for (int t = 0; t < 4; ++t)
#pragma unroll
        for (int j = 0; j < 4; ++j) {
            float bias = ub;
            if (!UNIB) { int d0 = qpos - (kpos0 + 16 * t + 4 * fq + j); d0 = d0 < -256 ? -256 : (d0 > 256 ? 256 : d0); bias = tab[d0 + 256]; }
            sv[4 * t + j] = sc[t][j] * scale + bias; mx = fmaxf(mx, sv[4 * t + j]); }
    mx = rows_max(mx);
    const float mnew = fmaxf(st.m, mx), alpha = __builtin_amdgcn_exp2f(st.m - mnew);
    float p[16]; float rs = 0.f;
#pragma unroll
    for (int j = 0; j < 16; ++j) { p[j] = __builtin_amdgcn_exp2f(sv[j] - mnew); rs += p[j]; }
    st.l = st.l * alpha + rs;
    P.grow = __builtin_amdgcn_ballot_w64(mnew > st.m) != 0ull; P.alpha = alpha;
    st.m = mnew;
    const v4u pw0 = {pk2(p[0], p[1]), pk2(p[2], p[3]), pk2(p[4], p[5]), pk2(p[6], p[7])}, pw1 = {pk2(p[8], p[9]), pk2(p[10], p[11]), pk2(p[12], p[13]), pk2(p[14], p[15])};
    P.pf0 = __builtin_bit_cast(bf16x8, pw0); P.pf1 = __builtin_bit_cast(bf16x8, pw1);
}
__device__ __forceinline__ void attn_pv(AttnState& st, const AttnP& P, const LAS unsigned char* vt, int fr, int fq) {
    if (P.grow) {
        asm volatile("" ::: "memory");
#pragma unroll
        for (int dt = 0; dt < 8; ++dt) st.o[dt] = st.o[dt] * P.alpha;
    }
#pragma unroll
    for (int dt = 0; dt < 8; ++dt) {
        const LAS unsigned char* vp = vt + (dt * 16 + fr) * AT_VROW + fq * 8;
        const v2u a0 = *(const LAS v2u*)vp, a1 = *(const LAS v2u*)(vp + 32), b0 = *(const LAS v2u*)(vp + 64), b1 = *(const LAS v2u*)(vp + 96);
        const v4u v0 = {a0.x, a0.y, a1.x, a1.y}, v1 = {b0.x, b0.y, b1.x, b1.y};
        st.o[dt] = MFMA16(__builtin_bit_cast(bf16x8, v0), P.pf0, st.o[dt]);
        st.o[dt] = MFMA16(__builtin_bit_cast(bf16x8, v1), P.pf1, st.o[dt]);
    }
}
#ifndef AT_PINGPONG
#define AT_PINGPONG 0
#endif
template <bool COMPUTE = true, int ABL = 0>
__device__ __forceinline__ void attn_phase(Frame& F, const bf16* Qb, bf16* Ob) {
    const int tid_ = fresh_tid(), lane_ = tid_ & 63, wave_ = __builtin_amdgcn_readfirstlane(tid_ >> 6); (void)lane_; (void)wave_;
    const bf16* Kb = (const bf16*)(F_WS + WS_KB); const bf16* VTb = (const bf16*)(F_WS + WS_VTB); const bf16* VTC = (const bf16*)(F_WS + WS_VTC);
    const int fr = lane_ & 15, fq = lane_ >> 4;
    for (int sidx = F.vcu; COMPUTE && !(ABL & 4) && sidx < 128; sidx += F.G) {
        const int b = sidx >> 4, h = sidx & 15; const size_t qrow = (size_t)TP + b * 16 + fr;
        LAS float* tab = (LAS float*)(F.lds + AT_ML + 1024);
        for (int i = tid_; i < 513; i += NWAVES * 64) tab[i] = F_IN(IN_REL)[h * 513 + i] * 1.4426950408889634f;
        __syncthreads();
        AttnState st;
#pragma unroll
        for (int dt = 0; dt < 8; ++dt) st.o[dt] = (f32x4){0.f, 0.f, 0.f, 0.f};
        st.m = -1e30f; st.l = 0.f;
        bf16x8 qf[4];
#pragma unroll
        for (int s = 0; s < 4; ++s) {
            const float* qp = (const float*)(F_WS + WS_ZSP) + (size_t)(b * 16 + fr) * D + h * 128 + s * 32 + fq * 8;
            f32x4 q0 = *(const f32x4*)qp, q1 = *(const f32x4*)(qp + 4);
#pragma unroll
            for (int pc = 1; pc < 8; ++pc) { q0 += *(const f32x4*)(qp + (size_t)pc * 128 * D); q1 += *(const f32x4*)(qp + (size_t)pc * 128 * D + 4); }
            const v4u qw = {pk2(q0.x, q0.y), pk2(q0.z, q0.w), pk2(q1.x, q1.y), pk2(q1.z, q1.w)};
            qf[s] = __builtin_bit_cast(bf16x8, qw); }
        const float* ck = F_IN(IN_CK) + (size_t)b * 512 * D + h * 128;
        for (int blk = wave_; blk < 17; blk += NWAVES) {
            if (blk < 16) {
                const int kb = blk * 32;
                bf16x8 kf[2][4];
#pragma unroll
                for (int t = 0; t < 2; ++t)
#pragma unroll
                    for (int s = 0; s < 4; ++s) kf[t][s] = cvt8(ck + (size_t)(kb + 16 * t + fr) * D + s * 32 + fq * 8);
                const bf16* vb = VTC + ((size_t)b * 2048 + h * 128 + fr) * 512 + kb + 4 * fq;
                v2u vr[8][2];
#pragma unroll
                for (int dt = 0; dt < 8; ++dt) { vr[dt][0] = *(const v2u*)(vb + (size_t)dt * 16 * 512); vr[dt][1] = *(const v2u*)(vb + (size_t)dt * 16 * 512 + 16); }
                attn_block(st, qf, kf, tab, 512 + fr, kb, 2, fq, [&](int dt, int half) { return vr[dt][half]; });
            } else {
                bf16x8 kf[2][4];
#pragma unroll
                for (int s = 0; s < 4; ++s) { kf[0][s] = *(const bf16x8*)(Kb + ((size_t)TP + b * 16 + fr) * D + h * 128 + s * 32 + fq * 8); kf[1][s] = kf[0][s]; }
                const bf16* vb = VTb + (size_t)(h * 128 + fr) * MP + TP + b * 16 + 4 * fq;
                attn_block(st, qf, kf, tab, 512 + fr, 512, 1, fq, [&](int dt, int half) { return *(const v2u*)(vb + (size_t)dt * 16 * MP + half * 16); });
            }
        }
        float l = rows_sum(st.l);
        LAS f32x4* OS = (LAS f32x4*)(F.lds + AT_OS); LAS f32x2v* ML = (LAS f32x2v*)(F.lds + AT_ML);
#pragma unroll
        for (int dt = 0; dt < 8; ++dt) OS[(wave_ * 8 + dt) * 64 + lane_] = st.o[dt];
        if (fq == 0) ML[wave_ * 16 + fr] = (f32x2v){st.m, l};
        __syncthreads();
        {
            float M = -1e30f; f32x2v ml[8];
#pragma unroll
            for (int w = 0; w < 8; ++w) { ml[w] = ML[w * 16 + fr]; M = fmaxf(M, ml[w].x); }
            float L = 0.f; f32x4 o = {0.f, 0.f, 0.f, 0.f};
#pragma unroll
            for (int w = 0; w < 8; ++w) { const float e = __builtin_amdgcn_exp2f(ml[w].x - M); L += ml[w].y * e; o += OS[(w * 8 + wave_) * 64 + lane_] * e; }
            o = o * (1.0f / L);
            *(v2u*)(Ob + qrow * D + h * 128 + wave_ * 16 + 4 * fq) = (v2u){pk2(o[0], o[1]), pk2(o[2], o[3])};
        }
        __syncthreads();
    }
    LAS unsigned char* Kt = F.lds + AT_KT; LAS unsigned char* Vt = F.lds + AT_VT; LAS float* TbAll = (LAS float*)(F.lds + AT_TAB);
    const int k_key = tid_ >> 4, k_seg = tid_ & 15, v_d = tid_ >> 2, v_seg = tid_ & 3;
    __syncthreads();
    for (int i = tid_; i < 16 * 513; i += NWAVES * 64) { const int hh = i / 513, e = i - hh * 513; TbAll[hh * 516 + e] = F_IN(IN_REL)[i] * 1.4426950408889634f; }
#define AT_LOAD(R, KG, VG, blk) do { R[0] = *(const v4u*)((KG) + (size_t)(blk) * 64 * D); R[1] = *(const v4u*)((KG) + (size_t)((blk) * 64 + 32) * D); R[2] = *(const v4u*)((VG) + (blk) * 64); R[3] = *(const v4u*)((VG) + (blk) * 64 + 32); } while (0)
#define AT_STORE2(R, kbuf, vbuf) do { LAS unsigned char* kd_ = Kt + (kbuf) * (64 * AT_KROW) + k_key * AT_KROW + k_seg * 16; *(LAS v4u*)kd_ = R[0]; *(LAS v4u*)(kd_ + 32 * AT_KROW) = R[1]; \
            LAS unsigned char* vd_ = Vt + (vbuf) * (128 * AT_VROW) + v_d * AT_VROW + v_seg * 16; *(LAS v2u*)vd_ = (v2u){R[2].x, R[2].y}; *(LAS v2u*)(vd_ + 8) = (v2u){R[2].z, R[2].w}; \
            *(LAS v2u*)(vd_ + 64) = (v2u){R[3].x, R[3].y}; *(LAS v2u*)(vd_ + 72) = (v2u){R[3].z, R[3].w}; } while (0)
#define AT_STORE(R, buf) AT_STORE2(R, buf, buf)
#define AT_TASK(ID, H_, QT_, QROW_, KBLO_, NBLK_, WLO_, WHI_, KG_, VG_) do { H_ = (ID) >> 7; const int cp_ = (ID) & 127, n0_ = 2 * cp_, n_ = n0_ + (wave_ >> 2); QT_ = 8 * cp_ + wave_; QROW_ = (size_t)QT_ * 16 + fr; \
            KBLO_ = (n0_ > 8 ? n0_ - 8 : 0) * 64; NBLK_ = ((n0_ + 2) * 64 - KBLO_) >> 6; WLO_ = (n_ > 8 ? n_ - 8 : 0) * 64; WHI_ = (n_ + 1) * 64; \
            KG_ = Kb + (size_t)(KBLO_ + k_key) * D + H_ * 128 + k_seg * 8; VG_ = VTb + (size_t)(H_ * 128 + v_d) * MP + KBLO_ + v_seg * 8; } while (0)
    const bool bal_ = AT_BALANCE && F.G == 256;
#define AT_TASKID(k) (bal_ ? ((k) < 7 ? F.vcu + 256 * (k) : (F.vcu >= 128 && (k) < 9 ? 1792 + 128 * ((k) - 7) + (F.vcu - 128) : 2048)) : F.vcu + F.G * (k))
    int id = F.vcu, kq_ = 0;
    if (id < 2048 && !(ABL & 8)) {
        int h, qt, kb_lo, nblk, wlo, whi; size_t qrow; const bf16* kg; const bf16* vg;
        AT_TASK(id, h, qt, qrow, kb_lo, nblk, wlo, whi, kg, vg);
        v4u r0[4]; bf16x8 qf[4];
#if AT_AHEAD2
        v4u r1[4];
        AT_LOAD(r0, kg, vg, 0); AT_LOAD(r1, kg, vg, 1);
#else
        AT_LOAD(r0, kg, vg, 0);
#endif
#pragma unroll
        for (int s = 0; s < 4; ++s) qf[s] = *(const bf16x8*)(Qb + qrow * D + h * 128 + s * 32 + fq * 8);
        AT_STORE(r0, 0);
        __syncthreads();
        int vs_ = 0, vprev_ = 0; (void)vs_; (void)vprev_;
        for (;;) {
            const int nid = AT_TASKID(kq_ + 1); const bool has_next = nid < 2048;
            int hN = 0, qtN = 0, kb_loN = 0, nblkN = 0, wloN = 0, whiN = 0; size_t qrowN = 0; const bf16* kgN = kg; const bf16* vgN = vg;
            if (has_next) AT_TASK(nid, hN, qtN, qrowN, kb_loN, nblkN, wloN, whiN, kgN, vgN);
            bf16x8 qn[4];
#pragma unroll
            for (int s = 0; s < 4; ++s) qn[s] = qf[s];
            const LAS float* Tb = TbAll + h * 516;
            AttnState st;
#pragma unroll
            for (int dt = 0; dt < 8; ++dt) st.o[dt] = (f32x4){0.f, 0.f, 0.f, 0.f};
            st.m = -1e30f; st.l = 0.f;
#if AT_SKEW
#define AT_QKS(kb_, kt_) do { if ((kb_) + 63 + 256 <= 16 * qt) attn_qks<true>(st, PP, qf, kt_, Tb, (int)qrow, kb_, fr, fq); else attn_qks<false>(st, PP, qf, kt_, Tb, (int)qrow, kb_, fr, fq); } while (0)
#define AT_STEP(bi, RL, RW) do { const int kb_ = kb_lo + 64 * (bi), cur_ = (bi) & 1; \
            if (!(ABL & 1)) { if ((bi) + 1 < nblk) AT_LOAD(r0, kg, vg, (bi) + 1); else if (has_next) AT_LOAD(r0, kgN, vgN, 0); } \
            if ((bi) + 1 == nblk && has_next) { _Pragma("unroll") for (int s = 0; s < 4; ++s) qn[s] = *(const bf16x8*)(Qb + qrowN * D + hN * 128 + s * 32 + fq * 8); } \
            const LAS unsigned char* kt = Kt + cur_ * (64 * AT_KROW); const LAS unsigned char* vt = Vt + vs_ * (128 * AT_VROW); \
            const bool act_ = kb_ >= wlo && kb_ < whi; \
            if (lo_) { if (act_) { \
                if (kb_ + 63 + 256 <= 16 * qt) attn_block64<1>(st, qf, kt, vt, Tb, (int)qrow, kb_, fr, fq); \
                else if (AT_MODE2 && 16 * qt + 15 - kb_ <= 256) attn_block64<2>(st, qf, kt, vt, Tb, (int)qrow, kb_, fr, fq); \
                else attn_block64<0>(st, qf, kt, vt, Tb, (int)qrow, kb_, fr, fq); } } \
            else { if (pend_) attn_pv(st, PP, Vt + vprev_ * (128 * AT_VROW), fr, fq); pend_ = false; if (act_) { AT_QKS(kb_, kt); pend_ = true; } } \
            const int vn_ = vs_ == 2 ? 0 : vs_ + 1; \
            if (!(ABL & 1)) { if ((bi) + 1 < nblk || has_next) AT_STORE2(r0, cur_ ^ 1, vn_); } \
            vprev_ = vs_; vs_ = vn_; \
            __syncthreads(); } while (0)
            AttnP PP; bool pend_ = false; const bool lo_ = wave_ < 4;
            for (int bi = 0; bi < nblk; bi += 2) { AT_STEP(bi, r0, r0); AT_STEP(bi + 1, r0, r0); }
            if (pend_) attn_pv(st, PP, Vt + vprev_ * (128 * AT_VROW), fr, fq);
#undef AT_QKS
#elif AT_PINGPONG
#define AT_QKS(kb_, kt_) do { if ((kb_) + 63 + 256 <= 16 * qt) attn_qks<true>(st, PP, qf, kt_, Tb, (int)qrow, kb_, fr, fq); else attn_qks<false>(st, PP, qf, kt_, Tb, (int)qrow, kb_, fr, fq); } while (0)
#define AT_STEP(bi, RL, RW) do { const int kb_ = kb_lo + 64 * (bi), cur_ = (bi) & 1; \
            if ((bi) + 2 < nblk) AT_LOAD(RL, kg, vg, (bi) + 2); else if (has_next) AT_LOAD(RL, kgN, vgN, (bi) + 2 - nblk); \
            if ((bi) + 1 == nblk && has_next) { _Pragma("unroll") for (int s = 0; s < 4; ++s) qn[s] = *(const bf16x8*)(Qb + qrowN * D + hN * 128 + s * 32 + fq * 8); } \
            const LAS unsigned char* kt = Kt + cur_ * (64 * AT_KROW); const LAS unsigned char* vt = Vt + cur_ * (128 * AT_VROW); const LAS unsigned char* vtp = Vt + (cur_ ^ 1) * (128 * AT_VROW); \
            const bool act_ = kb_ >= wlo && kb_ < whi; \
            if (lo_) { if (act_) AT_QKS(kb_, kt); } else { if (pend_) attn_pv(st, PP, vtp, fr, fq); pend_ = false; } \
            __syncthreads(); \
            if (lo_) { if (act_) attn_pv(st, PP, vt, fr, fq); } else { if (act_) { AT_QKS(kb_, kt); pend_ = true; } } \
            if ((bi) + 1 < nblk || has_next) AT_STORE(RW, cur_ ^ 1); \
            __syncthreads(); } while (0)
            AttnP PP; bool pend_ = false; const bool lo_ = wave_ < 4;
            for (int bi = 0; bi < nblk; bi += 2) { AT_STEP(bi, r0, r1); AT_STEP(bi + 1, r1, r0); }
            if (pend_) attn_pv(st, PP, Vt + 1 * (128 * AT_VROW), fr, fq);
#undef AT_QKS
#elif AT_AHEAD2
#define AT_STEP(bi, RL, RW) do { const int kb_ = kb_lo + 64 * (bi), cur_ = (bi) & 1; \
            if ((bi) + 2 < nblk) AT_LOAD(RL, kg, vg, (bi) + 2); else if (has_next) AT_LOAD(RL, kgN, vgN, (bi) + 2 - nblk); \
            if ((bi) + 1 == nblk && has_next) { _Pragma("unroll") for (int s = 0; s < 4; ++s) qn[s] = *(const bf16x8*)(Qb + qrowN * D + hN * 128 + s * 32 + fq * 8); } \
            if (COMPUTE && kb_ >= wlo && kb_ < whi) { \
                const LAS unsigned char* kt = Kt + cur_ * (64 * AT_KROW); const LAS unsigned char* vt = Vt + cur_ * (128 * AT_VROW); \
                if (kb_ + 63 + 256 <= 16 * qt) attn_block64<1>(st, qf, kt, vt, Tb, (int)qrow, kb_, fr, fq); \
                else if (AT_MODE2 && 16 * qt + 15 - kb_ <= 256) attn_block64<2>(st, qf, kt, vt, Tb, (int)qrow, kb_, fr, fq); \
                else attn_block64<0>(st, qf, kt, vt, Tb, (int)qrow, kb_, fr, fq); } \
            if ((bi) + 1 < nblk || has_next) AT_STORE(RW, cur_ ^ 1); \
            __syncthreads(); } while (0)
            for (int bi = 0; bi < nblk; bi += 2) { AT_STEP(bi, r0, r1); AT_STEP(bi + 1, r1, r0); }
#else
#define AT_STEP(bi, RL, RW) do { const int kb_ = kb_lo + 64 * (bi), cur_ = (bi) & 1; \
            if (!(ABL & 1)) { if ((bi) + 1 < nblk) AT_LOAD(r0, kg, vg, (bi) + 1); else if (has_next) AT_LOAD(r0, kgN, vgN, 0); } \
            if ((bi) + 1 == nblk && has_next) { _Pragma("unroll") for (int s = 0; s < 4; ++s) qn[s] = *(const bf16x8*)(Qb + qrowN * D + hN * 128 + s * 32 + fq * 8); } \
            if (COMPUTE && kb_ >= wlo && kb_ < whi) { \
                const LAS unsigned char* kt = Kt + cur_ * (64 * AT_KROW); const LAS unsigned char* vt = Vt + cur_ * (128 * AT_VROW); \
                if (kb_ + 63 + 256 <= 16 * qt) attn_block64<1>(st, qf, kt, vt, Tb, (int)qrow, kb_, fr, fq); \
                else if (AT_MODE2 && 16 * qt + 15 - kb_ <= 256) attn_block64<2>(st, qf, kt, vt, Tb, (int)qrow, kb_, fr, fq); \
                else attn_block64<0>(st, qf, kt, vt, Tb, (int)qrow, kb_, fr, fq); } \
            if (!(ABL & 1)) { if ((bi) + 1 < nblk || has_next) AT_STORE(r0, cur_ ^ 1); } \
            __syncthreads(); } while (0)
            for (int bi = 0; bi < nblk; bi += 2) { AT_STEP(bi, r0, r0); AT_STEP(bi + 1, r0, r0); }
#endif
#undef AT_STEP
            if (COMPUTE && (ABL & 2)) { float l = rows_sum(st.l); float acc_ = l;
#pragma unroll
                for (int dt = 0; dt < 8; ++dt) acc_ += st.o[dt][0] + st.o[dt][1] + st.o[dt][2] + st.o[dt][3];
                if (acc_ == 1.2345e-30f) Ob[0] = 0; }
            if (COMPUTE && !(ABL & 2)) {
                float l = rows_sum(st.l);
                const float inv = 1.0f / l;
#pragma unroll
                for (int dt = 0; dt < 8; ++dt) { const f32x4 o = st.o[dt] * inv;
                    *(v2u*)(Ob + qrow * D + h * 128 + dt * 16 + 4 * fq) = (v2u){pk2(o[0], o[1]), pk2(o[2], o[3])}; }
            }
            if (!has_next) break;
            id = nid; ++kq_; h = hN; qt = qtN; qrow = qrowN; kb_lo = kb_loN; nblk = nblkN; wlo = wloN; whi = whiN; kg = kgN; vg = vgN;
#pragma unroll
            for (int s = 0; s < 4; ++s) qf[s] = qn[s];
        }
    }
#undef AT_LOAD
#undef AT_STORE
#undef AT_STORE2
#undef AT_TASK
#undef AT_TASKID
}
#ifndef PHDUP
#define PHDUP 0
#endif
#ifndef PHSEL
#define PHSEL 0x7fffffff
#endif
#ifndef G2_SPLIT
#define G2_SPLIT 1
#endif
#ifndef PHDUP_N
#define PHDUP_N 1
#endif
#ifndef PHDUP_NOEPI
#define PHDUP_NOEPI 0
#endif
#define PHASE(bit, ...) do { if constexpr ((PHSEL >> (bit)) & 1) { __VA_ARGS__; } if constexpr ((PHDUP >> (bit)) & 1) { for (int d_ = 0; d_ < PHDUP_N; ++d_) { __syncthreads(); dup_skip_ = PHDUP_NOEPI != 0; __VA_ARGS__; dup_skip_ = false; } } } while (0)
#define GEMM2(ORD, ...) do { typedef __VA_ARGS__ Ops_; ORD S_; S_.G = F.G; S_.c = (int)blockIdx.x; Ops_ E_{F.a, F.G}; pg8::gemm_phase2<Ops_, ORD>(F.lds, S_, E_, dup_skip_); } while (0)
typedef pg8::SegOrder<65, 43, 0, 0, 0, 0, 0, 0, 32> OrdUp;
typedef pg8::SegOrder<64, 8, 0, 0, 0, 0, 21, 8, 86> OrdDown;
typedef pg8::SegOrder<64, 8, 0, 0, 0, 0, 8, 8, 32> OrdOut;
typedef pg8::SegOrder<65, 17, 8, 65, 0, 0, 0, 0, 32> OrdAin;
typedef pg8::SegOrder<65, 8, 8, 65, 65, 43, 0, 0, 32> OrdKVUp;
typedef pg8::SegOrder<64, 8, 0, 0, 0, 0, 8, 8, 32> OrdQ;

__global__ void __launch_bounds__(NWAVES * 64, 2) trunk_fwd(Args args) {
    extern __shared__ __attribute__((aligned(16))) unsigned char lds[];
    Frame F; bool dup_skip_ = false; (void)dup_skip_;
    F.lds = (LAS unsigned char*)lds;
    F.G = gridDim.x; { const int bx = blockIdx.x; F.vcu = (F.G % 8 == 0) ? (bx % 8) * (F.G / 8) + bx / 8 : bx; }
    F.a = (ArgsP)__builtin_amdgcn_kernarg_segment_ptr(); (void)args;
#define WSP (F.a->ws)
    volatile LAS unsigned* MISC = (volatile LAS unsigned*)(F.lds + MISC_OFF);
    for (int u = threadIdx.x; u < (LDS_BYTES - LDSCTL_OFF) / 4; u += NWAVES * 64) ((LAS unsigned*)(F.lds + LDSCTL_OFF))[u] = 0u;
    __syncthreads();
    XcdBarrier bar = xcd_barrier_post((unsigned*)(WSP + WS_CTL) + CW_BAR, MISC + 8);
#ifdef PROBE_BAR2
#define GRID_BAR() do { xcd_barrier(bar); xcd_barrier(bar); } while (0)
#else
#define GRID_BAR() xcd_barrier(bar)
#endif
#define H ((bf16*)(WSP + WS_H))
#define H2 ((bf16*)(WSP + WS_H2))
#define XA ((float*)(WSP + WS_XA))
#define Z ((float*)(WSP + WS_Z))
#define lng (F_IN(IN_LNG))
#define lnb (F_IN(IN_LNB))

    PHASE(1, p0_ada(F));
    __syncthreads();
    PHASE(0, p0_convert(F));
    GRID_BAR();
    PHASE(2, mod0_phase(F));
    GRID_BAR();
    PHASE(3, GEMM2(OrdUp, pg8::OpsUp<WS_WUP + 0 * SZ_WUP, 0, 0, 0>));
    GRID_BAR();
    PHASE(4, GEMM2(OrdDown, pg8::OpsRes<WS_HID, WS_WDN + 0 * SZ_WDN, FF, 0, ada_off(0, 0, 2), 1>));
    GRID_BAR();
    PHASE(5, ln_phase<0>(F, ada_off(0, 1, 0), ada_off(0, 1, 1), H, -1, -1, nullptr, ada_off(0, 0, 2), 0.5f, 21));
    GRID_BAR();
    PHASE(6, GEMM2(OrdAin, pg8::OpsAin));
    GRID_BAR();
    PHASE(8, gla_g2_phase(F, 0, G2_SPLIT && F.G > 240 ? 1024 : NCH * 4, F.vcu, F.G));
    GRID_BAR();
    PHASE(9, gla_pass1_phase(F));
    GRID_BAR();
    PHASE(15, gla_carry_phase(F));
    GRID_BAR();
    PHASE(11, gla_pass2_phase(F, !dup_skip_));
    GRID_BAR();
    PHASE(10, gla_gn_phase(F, H));
    GRID_BAR();
    PHASE(7, GEMM2(OrdOut, pg8::OpsRes<WS_H, WS_WAO, D, 1, ada_off(0, 1, 2), 0>));
    GRID_BAR();
    PHASE(5, ln_phase<1>(F, ada_off(0, 2, 0), ada_off(0, 2, 1), H, -1, -1, nullptr, ada_off(0, 1, 2), 1.0f, 8));
    GRID_BAR();
    PHASE(3, GEMM2(OrdUp, pg8::OpsUp<WS_WUP + 1 * SZ_WUP, 0, 0, 0>));
    GRID_BAR();
    PHASE(4, GEMM2(OrdDown, pg8::OpsRes<WS_HID, WS_WDN + 1 * SZ_WDN, FF, 2, ada_off(0, 2, 2), 1>));
    GRID_BAR();
    PHASE(5, ln_phase<2>(F, ada_off(1, 0, 0), ada_off(1, 0, 1), H, ADA_KV_SHIFT, ADA_KV_SCALE, H2, ada_off(0, 2, 2), 0.5f, 21));
    GRID_BAR();
    PHASE(12, GEMM2(OrdKVUp, pg8::OpsKVUp<WS_WUP + 2 * SZ_WUP, 0, 0, 0>));
    GRID_BAR();
    PHASE(4, GEMM2(OrdDown, pg8::OpsRes<WS_HID, WS_WDN + 2 * SZ_WDN, FF, 3, ada_off(1, 0, 2), 1>));
    GRID_BAR();
    PHASE(5, ln_phase<3>(F, ada_off(1, 1, 0), ada_off(1, 1, 1), H, -1, -1, nullptr, ada_off(1, 0, 2), 0.5f, 21));
    GRID_BAR();
    PHASE(13, GEMM2(OrdQ, pg8::OpsQ));
    GRID_BAR();
#ifndef ATT_REP
#define ATT_REP 1
#endif
    #ifdef ATT_SKEL
#ifndef ATT_SKEL_ABL
#define ATT_SKEL_ABL 0
#define ATT_SKEL_COMPUTE false
#endif
    attn_phase<true>(F, H2, H);
    for (int rep_ = 1; rep_ < ATT_REP; ++rep_) { __syncthreads(); attn_phase<ATT_SKEL_COMPUTE, ATT_SKEL_ABL>(F, H2, H); }
#else
    for (int rep_ = 0; rep_ < ATT_REP; ++rep_) { if (rep_) __syncthreads(); attn_phase<true>(F, H2, H); }
#endif
    GRID_BAR();
    PHASE(7, GEMM2(OrdOut, pg8::OpsRes<WS_H, WS_WBO, D, 4, ada_off(1, 1, 2), 0>));
    GRID_BAR();
    PHASE(5, ln_phase<4>(F, ada_off(1, 2, 0), ada_off(1, 2, 1), H, -1, -1, nullptr, ada_off(1, 1, 2), 1.0f, 8));
    GRID_BAR();
    PHASE(3, GEMM2(OrdUp, pg8::OpsUp<WS_WUP + 3 * SZ_WUP, 0, 0, 0>));
    GRID_BAR();
    PHASE(4, GEMM2(OrdDown, pg8::OpsRes<WS_HID, WS_WDN + 3 * SZ_WDN, FF, 5, ada_off(1, 2, 2), 1>));
    GRID_BAR();
    PHASE(5, ln_phase<5>(F, -1, -1, nullptr, -1, -1, nullptr, ada_off(1, 2, 2), 0.5f, 21));
#undef WSP
#undef H
#undef H2
#undef XA
#undef Z
#undef lng
#undef lnb
}

extern "C" void kernel_launch(void* const* d_in, const int* in_sizes, int n_in, void* d_out, int out_size, void* d_ws, size_t ws_size, hipStream_t stream) {
    static int grid = 0;
    if (grid == 0) {
        if (n_in != 24 || ws_size < WS_END) { fprintf(stderr, "kernel_launch: unexpected problem (n_in %d, ws %zu, need %zu)\n", n_in, ws_size, (size_t)WS_END); grid = -1; return; }
        int dev = 0, cus = 0, per_cu = 0;
        if (hipGetDevice(&dev) != hipSuccess || hipDeviceGetAttribute(&cus, hipDeviceAttributeMultiprocessorCount, dev) != hipSuccess) { grid = -1; return; }
        if (hipFuncSetAttribute((const void*)trunk_fwd, hipFuncAttributeMaxDynamicSharedMemorySize, LDS_BYTES) != hipSuccess) { fprintf(stderr, "kernel_launch: hipFuncSetAttribute failed\n"); grid = -1; return; }
        if (hipOccupancyMaxActiveBlocksPerMultiprocessor(&per_cu, (const void*)trunk_fwd, NWAVES * 64, LDS_BYTES) != hipSuccess || per_cu < 1) { fprintf(stderr, "kernel_launch: occupancy query says %d blocks per CU\n", per_cu); }
        (void)hipGetLastError();
        grid = cus;
    }
    if (grid < 0) return;
    (void)in_sizes; (void)out_size;
    if (hipMemsetAsync((char*)d_ws + WS_CTL, 0, CTL_ZERO_BYTES, stream) != hipSuccess) return;
    Args a{};
    for (int i = 0; i < 24; ++i) a.in[i] = (const float*)d_in[i];
    a.out = (float*)d_out; a.ws = (unsigned char*)d_ws;
    hipLaunchKernelGGL(trunk_fwd, dim3(grid), dim3(NWAVES * 64), LDS_BYTES, stream, a);
}
```
